# Optimizing an MI355X kernel written in HIP

```python
import math
import jax
import jax.numpy as jnp
from jax import lax
import numpy as np

D_MODEL = 1024
BATCH = 16
SEQ = 2048
DEPTH = 4

N_MIXERS = 3
EPS = 1e-6

S5_GROUP = 16
S5_GROUPS = D_MODEL // S5_GROUP
S5_STATE = 64
S5_DT_MIN = 1e-3
S5_DT_MAX = 1e-1

GLA_HEADS = 4
GLA_DK = D_MODEL // 2
GLA_DV = D_MODEL
GLA_HDK = GLA_DK // GLA_HEADS
GLA_HDV = GLA_DV // GLA_HEADS
GLA_GATE_RANK = 16
GLA_GATE_NORM = 16.0
GLA_CHUNK = 64
GLA_IN = 2 * GLA_DK + 2 * GLA_DV + GLA_GATE_RANK

SWA_HEAD_DIM = 64
SWA_Q_HEADS = D_MODEL // SWA_HEAD_DIM
SWA_KV_HEADS = 2
SWA_GROUP = SWA_Q_HEADS // SWA_KV_HEADS
SWA_WINDOW = 128
SWA_BLOCK = 128
SWA_QKV = (SWA_Q_HEADS + 2 * SWA_KV_HEADS) * SWA_HEAD_DIM
MASK_VALUE = -1e30

FFN_HIDDEN = 2816
N_EXPERTS = 8
TOP_K = 2
EXPERT_HIDDEN = 3584

kernel_name = 'hybrid_s5_gla_swa_moe_trunk'


def rmsnorm(x, g):
    xf = x.astype(jnp.float32)
    y = xf * lax.rsqrt(jnp.mean(xf * xf, axis=-1, keepdims=True) + EPS)
    return (y * g.astype(jnp.float32)).astype(x.dtype)


def alibi_slopes(n_heads):
    return jnp.exp2(-8.0 * jnp.arange(1, n_heads + 1, dtype=jnp.float32) / n_heads)


def s5_mixer(h, lam_re, lam_im, log_dt, b_re, b_im, c_re, c_im, d_skip, w_glu, b_glu):
    f32 = jnp.float32
    bsz, seqlen, _ = h.shape
    hf = h.astype(f32)
    u = hf.reshape(bsz, seqlen, S5_GROUPS, S5_GROUP)
    lam = lax.complex(lam_re.astype(f32), lam_im.astype(f32))
    dt = jnp.exp(log_dt.astype(f32))[:, None]
    lam_bar = jnp.exp(lam * dt)
    b = lax.complex(b_re.astype(f32), b_im.astype(f32))
    b_bar = ((lam_bar - 1.0) / lam)[..., None] * b
    bu = lax.complex(jnp.einsum('blgh,gph->blgp', u, jnp.real(b_bar)),
                     jnp.einsum('blgh,gph->blgp', u, jnp.imag(b_bar)))
    a = jnp.broadcast_to(lam_bar, (1, seqlen) + lam_bar.shape)

    def combine(e1, e2):
        a1, x1 = e1
        a2, x2 = e2
        return a1 * a2, a2 * x1 + x2

    _, states = lax.associative_scan(combine, (a, bu), axis=1)
    y = (jnp.einsum('blgp,ghp->blgh', jnp.real(states), c_re.astype(f32))
         - jnp.einsum('blgp,ghp->blgh', jnp.imag(states), c_im.astype(f32)))
    y = y.reshape(bsz, seqlen, D_MODEL) + d_skip.astype(f32) * hf
    y = jax.nn.gelu(y).astype(h.dtype)
    return y * jax.nn.sigmoid(y @ w_glu + b_glu)


def gla_mixer(h, w_in, w_g2, b_g2, g_norm, w_out):
    f32 = jnp.float32
    bsz, seqlen, _ = h.shape
    n_chunks = seqlen // GLA_CHUNK
    proj = h @ w_in
    q, k, v, r, g_low = jnp.split(
        proj, [GLA_DK, 2 * GLA_DK, 2 * GLA_DK + GLA_DV, 2 * GLA_DK + 2 * GLA_DV], axis=-1)
    log_alpha = jax.nn.log_sigmoid((g_low @ w_g2 + b_g2).astype(f32)) / GLA_GATE_NORM

    def chunked(t, hd):
        return t.astype(f32).reshape(bsz, n_chunks, GLA_CHUNK, GLA_HEADS, hd)

    q = chunked(q, GLA_HDK) * GLA_HDK ** -0.5
    k = chunked(k, GLA_HDK)
    v = chunked(v, GLA_HDV)
    gcum = jnp.cumsum(chunked(log_alpha, GLA_HDK), axis=2)
    g_last = gcum[:, :, -1:]
    q_s = q * jnp.exp(gcum)
    k_s = k * jnp.exp(-gcum)
    k_end = k * jnp.exp(g_last - gcum)
    causal = jnp.tril(jnp.ones((GLA_CHUNK, GLA_CHUNK), dtype=bool))
    scores = jnp.where(causal, jnp.einsum('bnihd,bnjhd->bnhij', q_s, k_s), 0.0)
    o_intra = jnp.einsum('bnhij,bnjhe->bnihe', scores, v)
    kv_chunk = jnp.einsum('bnjhd,bnjhe->bnhde', k_end, v)
    decay = jnp.exp(g_last[:, :, 0])

    def step(state, xs):
        q_n, kv_n, d_n = xs
        o_n = jnp.einsum('bihd,bhde->bihe', q_n, state)
        return d_n[..., None] * state + kv_n, o_n

    xs = (jnp.moveaxis(q_s, 1, 0), jnp.moveaxis(kv_chunk, 1, 0), jnp.moveaxis(decay, 1, 0))
    init = jnp.zeros((bsz, GLA_HEADS, GLA_HDK, GLA_HDV), f32)
    _, o_inter = lax.scan(step, init, xs)
    o = (o_intra + jnp.moveaxis(o_inter, 0, 1)).reshape(bsz, seqlen, GLA_HEADS, GLA_HDV)
    o = o * lax.rsqrt(jnp.mean(o * o, axis=-1, keepdims=True) + EPS)
    o = o.reshape(bsz, seqlen, GLA_DV) * g_norm.astype(f32)
    o = (o * jax.nn.silu(r.astype(f32))).astype(h.dtype)
    return o @ w_out


def swa_mixer(h, w_qkv, b_qkv, sinks, w_out, b_out):
    f32 = jnp.float32
    bsz, seqlen, _ = h.shape
    nb = seqlen // SWA_BLOCK
    qkv = h @ w_qkv + b_qkv
    q, k, v = jnp.split(
        qkv, [SWA_Q_HEADS * SWA_HEAD_DIM, (SWA_Q_HEADS + SWA_KV_HEADS) * SWA_HEAD_DIM], axis=-1)
    q = q.reshape(bsz, nb, SWA_BLOCK, SWA_KV_HEADS, SWA_GROUP, SWA_HEAD_DIM)
    k = k.reshape(bsz, nb, SWA_BLOCK, SWA_KV_HEADS, SWA_HEAD_DIM)
    v = v.reshape(bsz, nb, SWA_BLOCK, SWA_KV_HEADS, SWA_HEAD_DIM)

    def band(t):
        prev = jnp.pad(t, ((0, 0), (1, 0), (0, 0), (0, 0), (0, 0)))[:, :-1]
        return jnp.concatenate([prev, t], axis=2)

    kb = band(k)
    vb = band(v)
    scores = jnp.einsum('bnikgd,bnjkd->bnkgij', q, kb).astype(f32) * SWA_HEAD_DIM ** -0.5
    qi = jnp.arange(SWA_BLOCK)[:, None]
    kj = jnp.arange(2 * SWA_BLOCK)[None, :]
    dist = qi + SWA_BLOCK - kj
    in_window = (dist >= 0) & (dist < SWA_WINDOW)
    blk_valid = (jnp.arange(nb)[:, None, None] > 0) | (kj[None] >= SWA_BLOCK)
    mask = in_window[None] & blk_valid
    slopes = alibi_slopes(SWA_Q_HEADS).reshape(SWA_KV_HEADS, SWA_GROUP)
    scores = scores - slopes[:, :, None, None] * dist.astype(f32)
    scores = jnp.where(mask[None, :, None, None], scores, MASK_VALUE)
    sink = jnp.broadcast_to(sinks.astype(f32).reshape(SWA_KV_HEADS, SWA_GROUP, 1, 1),
                            scores.shape[:-1] + (1,))
    probs = jax.nn.softmax(jnp.concatenate([scores, sink], axis=-1), axis=-1)[..., :-1]
    o = jnp.einsum('bnkgij,bnjkd->bnikgd', probs.astype(h.dtype), vb)
    return o.reshape(bsz, seqlen, D_MODEL) @ w_out + b_out


def dense_swiglu(h, w_gate_up, w_down):
    gate, up = jnp.split(h @ w_gate_up, 2, axis=-1)
    return (jax.nn.silu(gate) * up) @ w_down


def moe_swiglu(h, w_router, w_gate_up, w_down):
    logits = (h @ w_router).astype(jnp.float32)
    top_vals, top_idx = lax.top_k(logits, TOP_K)
    top_w = jax.nn.softmax(top_vals, axis=-1)
    gates = jnp.sum(jax.nn.one_hot(top_idx, N_EXPERTS, dtype=jnp.float32) * top_w[..., None],
                    axis=-2).astype(h.dtype)
    out = jnp.zeros_like(h)
    for e in range(N_EXPERTS):
        out = out + gates[..., e:e + 1] * dense_swiglu(h, w_gate_up[e], w_down[e])
    return out


def _normal(key, shape, scale):
    return jax.random.normal(key, shape, jnp.float32) * scale


def _gain(key, n):
    return 1.0 + 0.02 * jax.random.normal(key, (n,), jnp.float32)


def _s5_params(p, keys, prefix):
    n = jnp.arange(S5_STATE, dtype=jnp.float32)
    gp = (S5_GROUPS, S5_STATE)
    p[prefix + 'lam_re'] = -0.5 + _normal(next(keys), gp, 0.01)
    p[prefix + 'lam_im'] = math.pi * n[None, :] + _normal(next(keys), gp, 0.01)
    p[prefix + 'log_dt'] = jax.random.uniform(next(keys), (S5_GROUPS,), jnp.float32,
                                              math.log(S5_DT_MIN), math.log(S5_DT_MAX))
    p[prefix + 'b_re'] = _normal(next(keys), (S5_GROUPS, S5_STATE, S5_GROUP), (2 * S5_GROUP) ** -0.5)
    p[prefix + 'b_im'] = _normal(next(keys), (S5_GROUPS, S5_STATE, S5_GROUP), (2 * S5_GROUP) ** -0.5)
    p[prefix + 'c_re'] = _normal(next(keys), (S5_GROUPS, S5_GROUP, S5_STATE), (2 * S5_STATE) ** -0.5)
    p[prefix + 'c_im'] = _normal(next(keys), (S5_GROUPS, S5_GROUP, S5_STATE), (2 * S5_STATE) ** -0.5)
    p[prefix + 'd'] = _normal(next(keys), (D_MODEL,), 0.5)
    p[prefix + 'w_glu'] = _normal(next(keys), (D_MODEL, D_MODEL), D_MODEL ** -0.5)
    p[prefix + 'b_glu'] = _normal(next(keys), (D_MODEL,), 0.02)


def _dense_params(p, keys, prefix):
    p[prefix + 'w_gate_up'] = _normal(next(keys), (D_MODEL, 2 * FFN_HIDDEN), D_MODEL ** -0.5)
    p[prefix + 'w_down'] = _normal(next(keys), (FFN_HIDDEN, D_MODEL), FFN_HIDDEN ** -0.5)


def _moe_params(p, keys, prefix):
    p[prefix + 'router'] = _normal(next(keys), (D_MODEL, N_EXPERTS), D_MODEL ** -0.5)
    p[prefix + 'w_gate_up'] = _normal(next(keys), (N_EXPERTS, D_MODEL, 2 * EXPERT_HIDDEN), D_MODEL ** -0.5)
    p[prefix + 'w_down'] = _normal(next(keys), (N_EXPERTS, EXPERT_HIDDEN, D_MODEL), EXPERT_HIDDEN ** -0.5)


def setup_inputs(seed: int = 0) -> dict:
    key = jax.random.key(seed)
    keys = iter(jax.random.split(key, 64))
    p = {}
    p['x'] = _normal(next(keys), (BATCH, SEQ, D_MODEL), 1.0)
    p['l0_ln1'] = _gain(next(keys), D_MODEL)
    _s5_params(p, keys, 'l0_s5_')
    p['l0_ln2'] = _gain(next(keys), D_MODEL)
    _dense_params(p, keys, 'l0_ffn_')
    p['l1_ln1'] = _gain(next(keys), D_MODEL)
    p['l1_gla_w_in'] = _normal(next(keys), (D_MODEL, GLA_IN), D_MODEL ** -0.5)
    p['l1_gla_w_g2'] = _normal(next(keys), (GLA_GATE_RANK, GLA_DK), GLA_GATE_RANK ** -0.5)
    p['l1_gla_b_g2'] = _normal(next(keys), (GLA_DK,), 0.02)
    p['l1_gla_norm'] = _gain(next(keys), GLA_DV)
    p['l1_gla_w_out'] = _normal(next(keys), (GLA_DV, D_MODEL), GLA_DV ** -0.5)
    p['l1_ln2'] = _gain(next(keys), D_MODEL)
    _moe_params(p, keys, 'l1_moe_')
    p['l2_ln1'] = _gain(next(keys), D_MODEL)
    p['l2_swa_w_qkv'] = _normal(next(keys), (D_MODEL, SWA_QKV), D_MODEL ** -0.5)
    p['l2_swa_b_qkv'] = _normal(next(keys), (SWA_QKV,), 0.02)
    p['l2_swa_sinks'] = _normal(next(keys), (SWA_Q_HEADS,), 0.5)
    p['l2_swa_w_out'] = _normal(next(keys), (D_MODEL, D_MODEL), D_MODEL ** -0.5)
    p['l2_swa_b_out'] = _normal(next(keys), (D_MODEL,), 0.02)
    p['l2_ln2'] = _gain(next(keys), D_MODEL)
    _dense_params(p, keys, 'l2_ffn_')
    p['l3_ln1'] = _gain(next(keys), D_MODEL)
    _s5_params(p, keys, 'l3_s5_')
    p['l3_ln2'] = _gain(next(keys), D_MODEL)
    _moe_params(p, keys, 'l3_moe_')
    p['ln_f'] = _gain(next(keys), D_MODEL)
    return p


def reference(x,
              l0_ln1, l0_s5_lam_re, l0_s5_lam_im, l0_s5_log_dt, l0_s5_b_re, l0_s5_b_im,
              l0_s5_c_re, l0_s5_c_im, l0_s5_d, l0_s5_w_glu, l0_s5_b_glu,
              l0_ln2, l0_ffn_w_gate_up, l0_ffn_w_down,
              l1_ln1, l1_gla_w_in, l1_gla_w_g2, l1_gla_b_g2, l1_gla_norm, l1_gla_w_out,
              l1_ln2, l1_moe_router, l1_moe_w_gate_up, l1_moe_w_down,
              l2_ln1, l2_swa_w_qkv, l2_swa_b_qkv, l2_swa_sinks, l2_swa_w_out, l2_swa_b_out,
              l2_ln2, l2_ffn_w_gate_up, l2_ffn_w_down,
              l3_ln1, l3_s5_lam_re, l3_s5_lam_im, l3_s5_log_dt, l3_s5_b_re, l3_s5_b_im,
              l3_s5_c_re, l3_s5_c_im, l3_s5_d, l3_s5_w_glu, l3_s5_b_glu,
              l3_ln2, l3_moe_router, l3_moe_w_gate_up, l3_moe_w_down,
              ln_f):
    layer_ln1 = (l0_ln1, l1_ln1, l2_ln1, l3_ln1)
    layer_ln2 = (l0_ln2, l1_ln2, l2_ln2, l3_ln2)
    mixer_params = (
        (l0_s5_lam_re, l0_s5_lam_im, l0_s5_log_dt, l0_s5_b_re, l0_s5_b_im,
         l0_s5_c_re, l0_s5_c_im, l0_s5_d, l0_s5_w_glu, l0_s5_b_glu),
        (l1_gla_w_in, l1_gla_w_g2, l1_gla_b_g2, l1_gla_norm, l1_gla_w_out),
        (l2_swa_w_qkv, l2_swa_b_qkv, l2_swa_sinks, l2_swa_w_out, l2_swa_b_out),
        (l3_s5_lam_re, l3_s5_lam_im, l3_s5_log_dt, l3_s5_b_re, l3_s5_b_im,
         l3_s5_c_re, l3_s5_c_im, l3_s5_d, l3_s5_w_glu, l3_s5_b_glu),
    )
    ffn_params = (
        (l0_ffn_w_gate_up, l0_ffn_w_down),
        (l1_moe_router, l1_moe_w_gate_up, l1_moe_w_down),
        (l2_ffn_w_gate_up, l2_ffn_w_down),
        (l3_moe_router, l3_moe_w_gate_up, l3_moe_w_down),
    )
    mixers = (s5_mixer, gla_mixer, swa_mixer)
    for i in range(DEPTH):
        x = x + mixers[i % N_MIXERS](rmsnorm(x, layer_ln1[i]), *mixer_params[i])
        channel = moe_swiglu if i % 2 == 1 else dense_swiglu
        x = x + channel(rmsnorm(x, layer_ln2[i]), *ffn_params[i])
    return rmsnorm(x, ln_f)
```

```cpp
#include <hip/hip_runtime.h>
#include <cstdio>
#include <cstdint>

#ifndef PROBE_MASK
#define PROBE_MASK 0ull
#define PROBE_N 2
#endif
#ifndef FFN2_FP8
#define FFN2_FP8 1
#endif
#ifndef FFN0_FP8
#define FFN0_FP8 0
#endif
#ifndef MK_PER_PHASE
#define MK_PER_PHASE 0
#endif

#define DI __device__ __forceinline__
#define LAS __attribute__((address_space(3)))
typedef unsigned short bf16_t;
typedef short bf16x8 __attribute__((ext_vector_type(8)));
typedef short s16x4 __attribute__((ext_vector_type(4)));
typedef float f32x4 __attribute__((ext_vector_type(4)));
typedef float f32x2 __attribute__((ext_vector_type(2)));
typedef unsigned u32x4 __attribute__((ext_vector_type(4)));
typedef unsigned u32x2 __attribute__((ext_vector_type(2)));

constexpr int T = 32768, D = 1024, SEQ = 2048, BATCH = 16;
constexpr int NWAVES = 8, NTHR = 512;
constexpr float EPS = 1e-6f;
constexpr int FFN_H = 2816, EXP_H = 3584, NEXP = 8;
constexpr int S5C = 32;
constexpr int S5ROWS = BATCH * (SEQ / S5C);
constexpr int S5K = S5C * 16;
constexpr int S5LD = S5K + 128;
constexpr int GLA_N = 3328;
constexpr int QKV_N = 1280;
constexpr int MOE_ROWS = 67584;
constexpr int MOE_TILES = 264;

constexpr size_t MiB = 1u << 20;
constexpr size_t WS_CTL = 0, CTL_ZERO_BYTES = 64 * 1024;
constexpr size_t WS_MISC = 1 * MiB;
constexpr size_t WS_WA = 4 * MiB;
constexpr size_t WS_XN = 174 * MiB;
constexpr size_t WS_ACT = 238 * MiB;
constexpr size_t WS_END = WS_ACT + 596 * MiB;
constexpr size_t WA_WGLU = 0, WA_TG = 2 * MiB, WA_FG = 42 * MiB, WA_FGU = 58 * MiB, WA_FDN = 69 * MiB;
constexpr size_t WA_WIN = 0, WA_WOUT = 7 * MiB;
constexpr size_t WA_MGU = 0, WA_MDN = 112 * MiB;
constexpr size_t WA_QKV = 0, WA_SWO = 3 * MiB;
constexpr size_t AC_UG = 0, AC_SLOC = 80 * MiB, AC_YMAT = 112 * MiB;
constexpr size_t AC_H = 0;
constexpr size_t AC_PROJ = 0, AC_GO = 208 * MiB, AC_KE = 272 * MiB, AC_SCB = 304 * MiB, AC_VTG = 320 * MiB, AC_DEC = 384 * MiB, AC_QSB = 386 * MiB;
constexpr size_t AC_XS = 0, AC_HID = 132 * MiB, AC_PART = 496 * MiB;
constexpr size_t HID_GS = (size_t)MOE_TILES * 256 * 32;
constexpr size_t SK_PART_STRIDE = (size_t)2048 * D;
constexpr size_t AC_QKV = 0, AC_AO = 80 * MiB;
constexpr size_t AC_XB = 424 * MiB;
constexpr size_t MS_SET = 1 * MiB;
constexpr size_t MS_RE = 0, MS_RW = 128 * 1024, MS_POS = 384 * 1024, MS_CNT = 640 * 1024, MS_TILE = 656 * 1024;
constexpr int CW_BAR = 1024;

constexpr int STAGE_BYTES = 131072;
constexpr int LDS_BYTES = 147456;
constexpr int LDS_MISC_OFF = LDS_BYTES - 2048;

typedef __bf16 bf16x2_t __attribute__((ext_vector_type(2)));
DI unsigned cvt_pk_bf16(float lo, float hi) { const bf16x2_t v = __builtin_convertvector((f32x2){lo, hi}, bf16x2_t); return __builtin_bit_cast(unsigned, v); }
typedef int i32x8 __attribute__((ext_vector_type(8)));
typedef int i32x4 __attribute__((ext_vector_type(4)));
DI unsigned cvt4_fp8(float a, float b, float c, float d) { int r = 0; r = __builtin_amdgcn_cvt_pk_fp8_f32(a, b, r, false); r = __builtin_amdgcn_cvt_pk_fp8_f32(c, d, r, true); return (unsigned)r; }
constexpr float W8_SCALE = 64.f;
DI float bf_lo(unsigned w) { return __uint_as_float(w << 16); }
DI float bf_hi(unsigned w) { return __uint_as_float(w & 0xffff0000u); }
DI float bf2f(bf16_t v) { return __uint_as_float(((unsigned)v) << 16); }
DI bf16_t f2bf(float f) { return (bf16_t)(cvt_pk_bf16(f, 0.f) & 0xffffu); }
DI float wave_sum(float v) {
#pragma unroll
    for (int o = 1; o < 64; o <<= 1) v += __shfl_xor(v, o);
    return v;
}
DI float sigmoid_f(float z) { return __builtin_amdgcn_rcpf(1.f + __builtin_amdgcn_exp2f(z * -1.4426950408889634f)); }
DI float silu_f(float z) { return z * sigmoid_f(z); }
DI f32x2 swiglu2(f32x2 g, f32x2 u) { const f32x2 t = g * -1.4426950408889634f; f32x2 e; e.x = __builtin_amdgcn_exp2f(t.x); e.y = __builtin_amdgcn_exp2f(t.y);
    const f32x2 d = e + 1.0f; f32x2 r; r.x = __builtin_amdgcn_rcpf(d.x); r.y = __builtin_amdgcn_rcpf(d.y); return (g * r) * u; }
DI f32x2 sigmoid2(f32x2 z) { const f32x2 t = z * -1.4426950408889634f; f32x2 e; e.x = __builtin_amdgcn_exp2f(t.x); e.y = __builtin_amdgcn_exp2f(t.y); const f32x2 d = e + 1.0f; f32x2 r; r.x = __builtin_amdgcn_rcpf(d.x); r.y = __builtin_amdgcn_rcpf(d.y); return r; }
DI f32x2 gelu_tanh2(f32x2 x) { const f32x2 u = (x * x * 0.044715f + 1.0f) * x * 1.5957691216f; return x * sigmoid2(u); }
DI float gelu_tanh_f(float x) { const float u = 1.5957691216f * (x + 0.044715f * x * x * x); return x * sigmoid_f(u); }
#define LDS_WAIT() asm volatile("s_waitcnt lgkmcnt(0)" ::: "memory")
#define LDS_BARRIER() do { asm volatile("s_waitcnt lgkmcnt(0)" ::: "memory"); __builtin_amdgcn_s_barrier(); asm volatile("" ::: "memory"); } while (0)

namespace pg8 {
constexpr int BM = 256, BK = 64, HALF = 128, HTB = HALF * BK * 2, NXCD = 8, WGM = 8;
__host__ __device__ __forceinline__ int lds_byte(int r, int c) { const int st = (r >> 4) * 2 + (c >> 5), rr = r & 15, cc = c & 31, ob = rr * 64 + cc * 2; return st * 1024 + (ob ^ (((ob >> 9) & 1) << 5)); }
__host__ __device__ __forceinline__ void stage_rc(int b, int& R, int& C) { const int st = b / 1024, sb = b % 1024, swz = sb ^ (((sb >> 9) & 1) << 5); R = (st >> 1) * 16 + swz / 64; C = (st & 1) * 32 + (swz % 64) / 2; }
__host__ __device__ __forceinline__ int perm32(int rho) { const int n = rho >> 4, i = rho & 15; return 8 * (i >> 2) + 4 * n + (i & 3); }

struct Unit { int pm, pn, aux; long aoff, boff; int kt = 0; long ooff = 0; };
struct Gemm { const bf16_t* A; const bf16_t* Bt; int lda, ldb, K; int a_cs16 = 32; };

DI bool tile_of(long L, int nM, int nN, int& pm, int& pn) {
    const int nwg = nM * nN; if (L >= nwg) return false;
    int wgid = (int)L; { const int q = nwg / NXCD, r = nwg % NXCD, xcd = wgid % NXCD, off = wgid / NXCD; wgid = (xcd < r ? xcd * (q + 1) : r * (q + 1) + (xcd - r) * q) + off; }
    const int nig = WGM * nN, gid = wgid / nig, fm = gid * WGM, gsz = (nM - fm) < WGM ? (nM - fm) : WGM;
    pm = fm + ((wgid % nig) % gsz); pn = (wgid % nig) / gsz; return true;
}
DI bool tile_of_bhot(long L, int nM, int nN, int& pm, int& pn) {
    const int nwg = nM * nN; if (L >= nwg) return false;
    int wgid = (int)L; { const int q = nwg / NXCD, r = nwg % NXCD, xcd = wgid % NXCD, off = wgid / NXCD; wgid = (xcd < r ? xcd * (q + 1) : r * (q + 1) + (xcd - r) * q) + off; }
    const int full = nN >> 2, idsFull = full * 4 * nM; int cg, r, cw;
    if (wgid < idsFull) { cg = wgid / (4 * nM); r = wgid % (4 * nM); cw = 4; } else { cg = full; r = wgid - idsFull; cw = nN & 3; }
    const int rb = r / (8 * cw), q = r % (8 * cw);
    pm = rb * 8 + (q & 7); pn = 4 * cg + (q >> 3); return true;
}
struct PlainOrder {
    int nM, nN, G, c; long atile, btile;
    DI void init(int M, int N, int G_, int c_, int lda, int ldb) { nM = M / BM; nN = N / BM; G = G_; c = c_; atile = (long)BM * lda * 2; btile = (long)BM * ldb * 2; }
    DI bool next(int i, Unit& u) const { int pm, pn; if (!tile_of((long)i * G + c, nM, nN, pm, pn)) return false; u.pm = pm; u.pn = pn; u.aux = 0; u.aoff = pm * atile; u.boff = pn * btile; return true; }
};
struct PlainOrderB : PlainOrder {
    DI bool next(int i, Unit& u) const { int pm, pn; if (!tile_of_bhot((long)i * G + c, nM, nN, pm, pn)) return false; u.pm = pm; u.pn = pn; u.aux = 0; u.aoff = pm * atile; u.boff = pn * btile; return true; }
};
struct BatchOrder {
    int ng, nM, nN, G, c; long atile, btile, astride, bstride;
    DI bool next(int i, Unit& u) const {
        const long L0 = (long)i * G + c; const int per = nM * nN, nwg = ng * per; if (L0 >= (long)nwg) return false;
        int L = (int)L0; { const int q = nwg / NXCD, r = nwg % NXCD, xcd = L % NXCD, off = L / NXCD; L = (xcd < r ? xcd * (q + 1) : r * (q + 1) + (xcd - r) * q) + off; }
        const int g = (int)(L / per), r = (int)(L % per); u.pm = r % nM; u.pn = r / nM; u.aux = g;
        u.aoff = g * astride + u.pm * atile; u.boff = g * bstride + u.pn * btile; return true; }
};
struct MoeOrder {
    int nM, nN, G, c; long atile, btile, bstride; const LAS int* tile_e; int rev;
    DI bool next(int i, Unit& u) const { int pm, pn; if (!tile_of((long)i * G + c, nM, nN, pm, pn)) return false; if (rev) pm = nM - 1 - pm; const int e = tile_e[pm];
        u.pm = pm; u.pn = pn; u.aux = e; u.aoff = pm * atile; u.boff = e * bstride + pn * btile; return true; }
};
constexpr int SK_NCH = 7, SK_CKT = 4;
DI void sk_split(int nM, int nN, int G, int& R, int& nsp) { const int nu = nM * nN; R = nu / G; nsp = (nu - R * G) / nN; if ((G % nN) || nsp > 8) { R = (nu + G - 1) / G; nsp = 0; } }
struct MoeOrderSK {
    int nM, nN, G, c; long atile, btile, bstride; const LAS int* tile_e; long part_off, part_stride, akt; int R, nsp;
    DI void init() { sk_split(nM, nN, G, R, nsp); }
    DI bool next(int i, Unit& u) const {
        if (i < R) { int pm, pn; if (!tile_of((long)i * G + c, nM - nsp, nN, pm, pn)) return false; pm = nM - 1 - pm; const int e = tile_e[pm];
            u.pm = pm; u.pn = pn; u.aux = e; u.kt = 0; u.ooff = 0; u.aoff = pm * atile; u.boff = e * bstride + pn * btile; return true; }
        const int j = (i - R) * G + c; if (j >= nsp * nN * SK_NCH) return false;
        const int ch = j % SK_NCH, q = j / SK_NCH, pn = q % nN, pm = q / nN, e = tile_e[pm]; const long ko = (long)ch * SK_CKT * 128;
        u.pm = pm; u.pn = pn; u.aux = e; u.kt = SK_CKT; u.ooff = ch ? part_off + (ch - 1) * part_stride : 0; u.aoff = pm * atile + (long)ch * SK_CKT * akt; u.boff = e * bstride + pn * btile + ko; return true; }
};

template <class Epi, class Sched, bool FP8 = false>
DI void gemm_phase(LAS unsigned char* lds, const int tid, const Gemm g, const Sched& S, const Epi& E) {
    const int wid = __builtin_amdgcn_readfirstlane(tid >> 6), lane = tid & 63, wr = wid >> 2, wc = wid & 3, fr = lane & 15, fq = lane >> 4;
    const int K = g.K, nt = K / BK;
    unsigned voffA[2], voffB[2];
#pragma unroll
    for (int i = 0; i < 2; ++i) { int R, C; stage_rc(tid * 16 + i * 8192, R, C); const int Rb = Epi::PERM ? ((R & ~31) + perm32(R & 31)) : R;
        voffA[i] = (unsigned)(R * g.lda) * 2u + (unsigned)(C >> 4) * (unsigned)g.a_cs16 + (unsigned)(C & 15) * 2u; voffB[i] = (unsigned)(Rb * g.ldb + C) * 2u; }
    const size_t kstep = (size_t)(BK * 2), kstepA = (size_t)4 * (size_t)g.a_cs16;
    const size_t hsA = (size_t)HALF * g.lda * 2, hsB = (size_t)HALF * g.ldb * 2;
    const unsigned ldsw = (unsigned)wid * 1024u;
    const int aoff = lds_byte(wr * 64 + fr, fq * 8), boff = lds_byte(wc * 32 + fr, fq * 8);
#define PG8_SA(b, h) (((b) * 2 + (h)) * HTB)
#define PG8_SB(b, h) ((4 + (b) * 2 + (h)) * HTB)
#define PG8_STAGE(bufoff, gbase, voff) do { _Pragma("unroll") for (int _i = 0; _i < 2; ++_i) \
        __builtin_amdgcn_global_load_lds((const unsigned*)((const char*)(gbase) + (voff)[_i]), (LAS unsigned*)(lds + (bufoff) + ldsw + _i * 8192), 16, 0, 0); } while (0)
#define PG8_LDA(dst, b, h) do { _Pragma("unroll") for (int m = 0; m < 4; ++m) _Pragma("unroll") for (int k = 0; k < 2; ++k) dst[m][k] = *(const LAS bf16x8*)(lds + PG8_SA(b, h) + aoff + m * 2048 + k * 1024); } while (0)
#define PG8_LDB(dst, b, h) do { _Pragma("unroll") for (int n = 0; n < 2; ++n) _Pragma("unroll") for (int k = 0; k < 2; ++k) dst[n][k] = *(const LAS bf16x8*)(lds + PG8_SB(b, h) + boff + n * 2048 + k * 1024); } while (0)
#define PG8_MMA(ai, bj, At, Bt) do { if constexpr (FP8) __builtin_amdgcn_sched_barrier(0); __builtin_amdgcn_s_setprio(1); _Pragma("unroll") for (int m = 0; m < 4; ++m) _Pragma("unroll") for (int n = 0; n < 2; ++n) { \
        if constexpr (FP8) { const i32x8 b8 = __builtin_shufflevector(__builtin_bit_cast(i32x4, Bt[n][0]), __builtin_bit_cast(i32x4, Bt[n][1]), 0, 1, 2, 3, 4, 5, 6, 7), a8 = __builtin_shufflevector(__builtin_bit_cast(i32x4, At[m][0]), __builtin_bit_cast(i32x4, At[m][1]), 0, 1, 2, 3, 4, 5, 6, 7); \
            asm("v_mfma_scale_f32_16x16x128_f8f6f4 %0, %1, %2, %0, %3, %4 op_sel_hi:[0,0,0]" : "+v"(acc[ai][bj][m][n]) : "v"(b8), "v"(a8), "v"(sc_b), "v"(sc_a)); } \
        else { _Pragma("unroll") for (int k = 0; k < 2; ++k) acc[ai][bj][m][n] = __builtin_amdgcn_mfma_f32_16x16x32_bf16(Bt[n][k], At[m][k], acc[ai][bj][m][n], 0, 0, 0); } } __builtin_amdgcn_s_setprio(0); if constexpr (FP8) __builtin_amdgcn_sched_barrier(0); } while (0)
#define PG8_WAIT_V(n) asm volatile("s_waitcnt vmcnt(" #n ")" ::: "memory")
#define PG8_WAIT_L(n) asm volatile("s_waitcnt lgkmcnt(" #n ")" ::: "memory")
#define PG8_BAR __builtin_amdgcn_s_barrier()
#define PG8_SCHED __builtin_amdgcn_sched_barrier(0)
    Unit cur, nxt; int ui = 0;
    if (!S.next(0, cur)) return;
    const int sc_b = 121, sc_a = 127;
    f32x4 acc[2][2][4][2];
#pragma unroll
    for (int a = 0; a < 2; ++a)
#pragma unroll
        for (int b = 0; b < 2; ++b)
#pragma unroll
            for (int m = 0; m < 4; ++m)
#pragma unroll
                for (int n = 0; n < 2; ++n) acc[a][b][m][n] = (f32x4){0.f, 0.f, 0.f, 0.f};
    bf16x8 At[4][2], B0[2][2], B1[2][2];
    const char* cA = (const char*)g.A + cur.aoff; const char* cB = (const char*)g.Bt + cur.boff;
    PG8_STAGE(PG8_SB(0, 0), cB, voffB); PG8_STAGE(PG8_SB(0, 1), cB + hsB, voffB); PG8_STAGE(PG8_SA(0, 0), cA, voffA); PG8_STAGE(PG8_SA(0, 1), cA + hsA, voffA);
    if (wr == 1) PG8_BAR;
    PG8_WAIT_V(2); PG8_BAR;
    PG8_STAGE(PG8_SB(1, 0), cB + kstep, voffB); PG8_STAGE(PG8_SA(1, 0), cA + kstepA, voffA); PG8_STAGE(PG8_SB(1, 1), cB + hsB + kstep, voffB);
    PG8_WAIT_V(6); PG8_BAR;
    for (;;) {
        const bool has_next = S.next(ui + 1, nxt);
        const char* nA = has_next ? (const char*)g.A + nxt.aoff : cA; const char* nB = has_next ? (const char*)g.Bt + nxt.boff : cB;
        const int ntu = cur.kt ? cur.kt : nt;
        for (int t = 0; t < ntu; t += 2) {
            const bool last = (t == ntu - 2);
            const char* a1 = cA + (size_t)(t + 1) * kstepA;
            const char* a2 = last ? nA : cA + (size_t)(t + 2) * kstepA; const char* b2 = last ? nB : cB + (size_t)(t + 2) * kstep;
            const char* a3 = a2 + kstepA; const char* b3 = b2 + kstep;
            PG8_LDB(B0, 0, 0); PG8_LDB(B1, 0, 1); PG8_SCHED; PG8_LDA(At, 0, 0); PG8_STAGE(PG8_SA(1, 1), a1 + hsA, voffA);
            PG8_WAIT_V(8); PG8_WAIT_L(0); PG8_BAR; PG8_MMA(0, 0, At, B0); PG8_MMA(0, 1, At, B1); PG8_BAR; PG8_SCHED;
            PG8_LDA(At, 0, 1); PG8_STAGE(PG8_SB(0, 0), b2, voffB); PG8_STAGE(PG8_SB(0, 1), b2 + hsB, voffB); PG8_STAGE(PG8_SA(0, 0), a2, voffA);
            PG8_WAIT_V(8); PG8_WAIT_L(0); PG8_BAR; PG8_MMA(1, 0, At, B0); PG8_MMA(1, 1, At, B1); PG8_BAR; PG8_SCHED;
            PG8_LDB(B0, 1, 0); PG8_LDB(B1, 1, 1); PG8_SCHED; PG8_LDA(At, 1, 0); PG8_STAGE(PG8_SA(0, 1), a2 + hsA, voffA);
            PG8_WAIT_V(8); PG8_WAIT_L(0); PG8_BAR; PG8_MMA(0, 0, At, B0); PG8_MMA(0, 1, At, B1); PG8_BAR; PG8_SCHED;
            PG8_LDA(At, 1, 1); PG8_STAGE(PG8_SB(1, 0), b3, voffB); PG8_STAGE(PG8_SB(1, 1), b3 + hsB, voffB); PG8_STAGE(PG8_SA(1, 0), a3, voffA);
            PG8_WAIT_V(8); PG8_WAIT_L(0); PG8_BAR; PG8_MMA(1, 0, At, B0); PG8_MMA(1, 1, At, B1); PG8_BAR; PG8_SCHED;
        }
        if (wr == 0) PG8_BAR;
        if constexpr (FP8) asm volatile("s_nop 15\n\ts_nop 15" ::: "memory");
        { int t2 = tid; asm volatile("" : "+v"(t2)); const int l2 = t2 & 63; E(acc, cur, wr, wc, l2 & 15, l2 >> 4); }
        if (!has_next) break;
#pragma unroll
        for (int a = 0; a < 2; ++a)
#pragma unroll
            for (int b = 0; b < 2; ++b)
#pragma unroll
                for (int m = 0; m < 4; ++m)
#pragma unroll
                    for (int n = 0; n < 2; ++n) acc[a][b][m][n] = (f32x4){0.f, 0.f, 0.f, 0.f};
        cur = nxt; cA = nA; cB = nB; ++ui;
        if (wr == 1) PG8_BAR;
    }
    PG8_WAIT_V(0);
    PG8_BAR;
#undef PG8_SA
#undef PG8_SB
#undef PG8_STAGE
#undef PG8_LDA
#undef PG8_LDB
#undef PG8_MMA
#undef PG8_WAIT_V
#undef PG8_WAIT_L
#undef PG8_BAR
#undef PG8_SCHED
}

typedef const f32x4 (&AccRef)[2][2][4][2];

struct EpiStoreBf16 {
    static constexpr bool PERM = true;
    bf16_t* O; int ldc; const float* bias;
    DI void operator()(AccRef acc, const Unit& u, int wr, int wc, int fr, int fq) const {
        const int row0 = u.pm * BM + wr * 64 + fr, col0 = u.pn * BM + wc * 32 + 8 * fq;
        f32x4 bv[2][2];
#pragma unroll
        for (int bj = 0; bj < 2; ++bj)
#pragma unroll
            for (int n = 0; n < 2; ++n) bv[bj][n] = bias ? *(const f32x4*)(bias + col0 + bj * HALF + 4 * n) : (f32x4){0.f, 0.f, 0.f, 0.f};
#pragma unroll
        for (int ai = 0; ai < 2; ++ai)
#pragma unroll
            for (int m = 0; m < 4; ++m) { bf16_t* rowp = O + u.ooff + (size_t)(row0 + ai * HALF + m * 16) * ldc + col0;
#pragma unroll
                for (int bj = 0; bj < 2; ++bj) { const f32x4 v0 = acc[ai][bj][m][0] + bv[bj][0], v1 = acc[ai][bj][m][1] + bv[bj][1];
                    u32x4 w; w.x = cvt_pk_bf16(v0[0], v0[1]); w.y = cvt_pk_bf16(v0[2], v0[3]); w.z = cvt_pk_bf16(v1[0], v1[1]); w.w = cvt_pk_bf16(v1[2], v1[3]);
                    *(u32x4*)(rowp + bj * HALF) = w; } }
    }
};
struct EpiSwiGLU {
    static constexpr bool PERM = true;
    bf16_t* H; int ldh;
    DI void operator()(AccRef acc, const Unit& u, int wr, int wc, int fr, int fq) const {
        const int row0 = u.pm * BM + wr * 64 + fr, col0 = u.pn * HALF + wc * 32 + 8 * fq;
#pragma unroll
        for (int ai = 0; ai < 2; ++ai)
#pragma unroll
            for (int m = 0; m < 4; ++m) { bf16_t* rowp = H + (size_t)(row0 + ai * HALF + m * 16) * ldh + col0;
                const f32x4 g0 = acc[ai][0][m][0], g1 = acc[ai][0][m][1], u0 = acc[ai][1][m][0], u1 = acc[ai][1][m][1];
                const f32x2 h0 = swiglu2((f32x2){g0[0], g0[1]}, (f32x2){u0[0], u0[1]}), h1 = swiglu2((f32x2){g0[2], g0[3]}, (f32x2){u0[2], u0[3]});
                const f32x2 h2 = swiglu2((f32x2){g1[0], g1[1]}, (f32x2){u1[0], u1[1]}), h3 = swiglu2((f32x2){g1[2], g1[3]}, (f32x2){u1[2], u1[3]});
                u32x4 w; w.x = cvt_pk_bf16(h0.x, h0.y); w.y = cvt_pk_bf16(h1.x, h1.y); w.z = cvt_pk_bf16(h2.x, h2.y); w.w = cvt_pk_bf16(h3.x, h3.y);
                *(u32x4*)rowp = w; }
    }
};
struct EpiSwiGLU8 {
    static constexpr bool PERM = true;
    unsigned char* H; size_t gs;
    DI void operator()(AccRef acc, const Unit& u, int wr, int wc, int fr, int fq) const {
        const int row0 = u.pm * BM + wr * 64 + fr;
        unsigned char* base = H + (size_t)(4 * u.pn + wc) * gs + 8 * fq;
#pragma unroll
        for (int ai = 0; ai < 2; ++ai)
#pragma unroll
            for (int m = 0; m < 4; ++m) { unsigned char* rowp = base + (size_t)(row0 + ai * HALF + m * 16) * 32;
                const f32x4 g0 = acc[ai][0][m][0], g1 = acc[ai][0][m][1], u0 = acc[ai][1][m][0], u1 = acc[ai][1][m][1];
                const f32x2 h0 = swiglu2((f32x2){g0[0], g0[1]}, (f32x2){u0[0], u0[1]}), h1 = swiglu2((f32x2){g0[2], g0[3]}, (f32x2){u0[2], u0[3]});
                const f32x2 h2 = swiglu2((f32x2){g1[0], g1[1]}, (f32x2){u1[0], u1[1]}), h3 = swiglu2((f32x2){g1[2], g1[3]}, (f32x2){u1[2], u1[3]});
                u32x2 w; w.x = cvt4_fp8(h0.x, h0.y, h1.x, h1.y); w.y = cvt4_fp8(h2.x, h2.y, h3.x, h3.y);
                *(u32x2*)rowp = w; }
    }
};
struct EpiResAdd {
    static constexpr bool PERM = true;
    bf16_t* X; const float* bias;
    DI void operator()(AccRef acc, const Unit& u, int wr, int wc, int fr, int fq) const {
        const int row0 = u.pm * BM + wr * 64 + fr, col0 = u.pn * BM + wc * 32 + 8 * fq;
        f32x4 bv[2][2];
#pragma unroll
        for (int bj = 0; bj < 2; ++bj)
#pragma unroll
            for (int n = 0; n < 2; ++n) bv[bj][n] = bias ? *(const f32x4*)(bias + col0 + bj * HALF + 4 * n) : (f32x4){0.f, 0.f, 0.f, 0.f};
        u32x4 xv[2][2];
#define RA_LOAD(r, buf) do { const bf16_t* rp_ = X + (size_t)(row0 + ((r) >> 2) * HALF + ((r) & 3) * 16) * D + col0; \
            _Pragma("unroll") for (int bj = 0; bj < 2; ++bj) xv[buf][bj] = *(const u32x4*)(rp_ + bj * HALF); } while (0)
        RA_LOAD(0, 0);
#pragma unroll
        for (int r = 0; r < 8; ++r) { const int ai = r >> 2, m = r & 3; bf16_t* rowp = X + (size_t)(row0 + ai * HALF + m * 16) * D + col0;
            if (r < 7) RA_LOAD(r + 1, (r + 1) & 1);
#pragma unroll
            for (int bj = 0; bj < 2; ++bj) { const u32x4 xw = xv[r & 1][bj]; const f32x4 a0 = acc[ai][bj][m][0] + bv[bj][0], a1 = acc[ai][bj][m][1] + bv[bj][1];
                u32x4 w; w.x = cvt_pk_bf16(bf_lo(xw.x) + a0[0], bf_hi(xw.x) + a0[1]); w.y = cvt_pk_bf16(bf_lo(xw.y) + a0[2], bf_hi(xw.y) + a0[3]);
                w.z = cvt_pk_bf16(bf_lo(xw.z) + a1[0], bf_hi(xw.z) + a1[1]); w.w = cvt_pk_bf16(bf_lo(xw.w) + a1[2], bf_hi(xw.w) + a1[3]);
                *(u32x4*)(rowp + bj * HALF) = w; }
            asm volatile("" ::: "memory"); }
#undef RA_LOAD
    }
};
struct EpiSloc {
    static constexpr bool PERM = false;
    float* SL;
    DI void operator()(AccRef acc, const Unit& u, int wr, int wc, int fr, int fq) const {
        const int row0 = u.pm * BM + wr * 64 + fr, col0 = wc * 32 + 4 * fq;
#pragma unroll
        for (int ai = 0; ai < 2; ++ai)
#pragma unroll
            for (int m = 0; m < 4; ++m) { float* rowp = SL + ((size_t)u.aux * S5ROWS + row0 + ai * HALF + m * 16) * 128 + col0;
#pragma unroll
                for (int n = 0; n < 2; ++n) *(f32x4*)(rowp + n * 16) = acc[ai][0][m][n]; }
    }
};
struct EpiS5Y {
    static constexpr bool PERM = true;
    bf16_t* Y;
    DI void operator()(AccRef acc, const Unit& u, int wr, int wc, int fr, int fq) const {
        const int g = u.aux, row0 = u.pm * BM + wr * 64 + fr, col0 = u.pn * BM + wc * 32 + 8 * fq, h0 = col0 & 15;
#pragma unroll
        for (int ai = 0; ai < 2; ++ai)
#pragma unroll
            for (int m = 0; m < 4; ++m) { const int R = row0 + ai * HALF + m * 16;
#pragma unroll
                for (int bj = 0; bj < 2; ++bj) { const int c = col0 + bj * HALF, l = c >> 4;
                    const f32x4 a0 = acc[ai][bj][m][0], a1 = acc[ai][bj][m][1];
                    const f32x2 y0 = gelu_tanh2((f32x2){a0[0], a0[1]}), y1 = gelu_tanh2((f32x2){a0[2], a0[3]}), y2 = gelu_tanh2((f32x2){a1[0], a1[1]}), y3 = gelu_tanh2((f32x2){a1[2], a1[3]});
                    u32x4 w; w.x = cvt_pk_bf16(y0.x, y0.y); w.y = cvt_pk_bf16(y1.x, y1.y); w.z = cvt_pk_bf16(y2.x, y2.y); w.w = cvt_pk_bf16(y3.x, y3.y);
                    *(u32x4*)(Y + ((size_t)g * T + (size_t)R * S5C + l) * 16 + h0) = w; } }
    }
};
template <bool XBF>
struct EpiGlu {
    static constexpr bool PERM = true;
    const void* XIN; bf16_t* XOUT; const bf16_t* Y; const float* bias;
    DI void operator()(AccRef acc, const Unit& u, int wr, int wc, int fr, int fq) const {
        const int row0 = u.pm * BM + wr * 64 + fr, col0 = u.pn * BM + wc * 32 + 8 * fq;
        f32x4 bv[2][2];
#pragma unroll
        for (int bj = 0; bj < 2; ++bj)
#pragma unroll
            for (int n = 0; n < 2; ++n) bv[bj][n] = *(const f32x4*)(bias + col0 + bj * HALF + 4 * n);
        f32x4 xf[2][2][2]; u32x4 xb[2][2], yw[2][2];
#define GL_LOAD(r, buf) do { const int row_ = row0 + ((r) >> 2) * HALF + ((r) & 3) * 16; \
            _Pragma("unroll") for (int bj = 0; bj < 2; ++bj) { const int cc = col0 + bj * HALF; \
                if constexpr (XBF) xb[buf][bj] = *(const u32x4*)((const bf16_t*)XIN + (size_t)row_ * D + cc); \
                else { xf[buf][bj][0] = *(const f32x4*)((const float*)XIN + (size_t)row_ * D + cc); xf[buf][bj][1] = *(const f32x4*)((const float*)XIN + (size_t)row_ * D + cc + 4); } \
                yw[buf][bj] = *(const u32x4*)(Y + ((size_t)(cc >> 4) * T + row_) * 16 + (cc & 15)); } } while (0)
        GL_LOAD(0, 0);
#pragma unroll
        for (int r = 0; r < 8; ++r) { const int ai = r >> 2, m = r & 3, b = r & 1; const size_t off = (size_t)(row0 + ai * HALF + m * 16) * D + col0;
            if (r < 7) GL_LOAD(r + 1, (r + 1) & 1);
#pragma unroll
            for (int bj = 0; bj < 2; ++bj) { const f32x4 z0 = acc[ai][bj][m][0] + bv[bj][0], z1 = acc[ai][bj][m][1] + bv[bj][1];
                const f32x2 s0 = sigmoid2((f32x2){z0[0], z0[1]}), s1 = sigmoid2((f32x2){z0[2], z0[3]}), s2 = sigmoid2((f32x2){z1[0], z1[1]}), s3 = sigmoid2((f32x2){z1[2], z1[3]});
                const u32x4 y = yw[b][bj]; f32x2 x0, x1, x2, x3;
                if constexpr (XBF) { const u32x4 x = xb[b][bj]; x0 = (f32x2){bf_lo(x.x), bf_hi(x.x)}; x1 = (f32x2){bf_lo(x.y), bf_hi(x.y)}; x2 = (f32x2){bf_lo(x.z), bf_hi(x.z)}; x3 = (f32x2){bf_lo(x.w), bf_hi(x.w)}; }
                else { const f32x4 xa = xf[b][bj][0], xc = xf[b][bj][1]; x0 = (f32x2){xa[0], xa[1]}; x1 = (f32x2){xa[2], xa[3]}; x2 = (f32x2){xc[0], xc[1]}; x3 = (f32x2){xc[2], xc[3]}; }
                const f32x2 o0 = x0 + (f32x2){bf_lo(y.x), bf_hi(y.x)} * s0, o1 = x1 + (f32x2){bf_lo(y.y), bf_hi(y.y)} * s1, o2 = x2 + (f32x2){bf_lo(y.z), bf_hi(y.z)} * s2, o3 = x3 + (f32x2){bf_lo(y.w), bf_hi(y.w)} * s3;
                *(u32x4*)(XOUT + off + bj * HALF) = (u32x4){cvt_pk_bf16(o0.x, o0.y), cvt_pk_bf16(o1.x, o1.y), cvt_pk_bf16(o2.x, o2.y), cvt_pk_bf16(o3.x, o3.y)}; }
            asm volatile("" ::: "memory"); }
#undef GL_LOAD
    }
};
}

#define XB_TMO      128
#define XB_XCNT(j)  (256  + 64 * (j))
#define XB_XSUB(j)  (1280 + 64 * (j))
#define XB_XGEN(j)  (2304 + 64 * (j))
#define XB_TOP      3328
#define XB_TOPGEN   3392
#define XCD_BAR_WORDS 3456
#define XB_SPIN_CAP (1u << 18)
__device__ __forceinline__ unsigned xb_ld(unsigned* p)              { return __hip_atomic_load(p, __ATOMIC_RELAXED, __HIP_MEMORY_SCOPE_AGENT); }
__device__ __forceinline__ unsigned xb_add(unsigned* p, unsigned v) { return __hip_atomic_fetch_add(p, v, __ATOMIC_RELAXED, __HIP_MEMORY_SCOPE_AGENT); }
__device__ __forceinline__ unsigned xb_xcc_id() { return (unsigned)__builtin_amdgcn_s_getreg((3 << 11) | 20) & 0xFu; }
#define XB_SPIN(cond, bar) do { unsigned _sp = 0; while (cond) { __builtin_amdgcn_s_sleep(1); \
    if ((++_sp & 255u) == 0u) { if (xb_ld(&(bar)[XB_TMO])) break; if (_sp > XB_SPIN_CAP) { atomicAdd(&(bar)[XB_TMO], 1u); break; } } } } while (0)
struct XcdBarrier { unsigned* bar; unsigned x; volatile LAS unsigned* st; };
__device__ __forceinline__ XcdBarrier xcd_barrier_post(unsigned* bar, volatile LAS unsigned* st) {
    XcdBarrier b; b.bar = bar; b.x = xb_xcc_id(); b.st = st;
    if (threadIdx.x == 0) (void)xb_add(&bar[XB_XCNT(b.x)], 1u);
    return b;
}
__device__ __forceinline__ void xcd_barrier_complete(unsigned* bar, unsigned x, unsigned& nloc, unsigned& nx) {
    const unsigned G = gridDim.x * gridDim.y * gridDim.z;
    unsigned sum, cnt, mine, sp = 0u;
    for (;;) {
        sum = 0u; cnt = 0u; mine = 0u;
#pragma unroll
        for (unsigned j = 0; j < 16; ++j) { const unsigned c = xb_ld(&bar[XB_XCNT(j)]); sum += c; cnt += (c > 0u) ? 1u : 0u; mine = (j == x) ? c : mine; }
        if (sum == G) break;
        __builtin_amdgcn_s_sleep(1);
        if ((++sp & 255u) == 0u) { if (xb_ld(&bar[XB_TMO])) break; if (sp > XB_SPIN_CAP) { atomicAdd(&bar[XB_TMO], 1u); break; } }
    }
    nloc = mine > 0u ? mine : 1u; nx = cnt > 0u ? cnt : 1u;
}
__device__ __forceinline__ void xcd_barrier(const XcdBarrier& b) {
    asm volatile("s_waitcnt vmcnt(0)" ::: "memory");
    __syncthreads();
    if (threadIdx.x == 0) {
        unsigned* bar = b.bar;
        __builtin_amdgcn_s_waitcnt(0);
        unsigned nloc = b.st[0], nx = b.st[1];
        if (nloc == 0u) { xcd_barrier_complete(bar, b.x, nloc, nx); b.st[0] = nloc; b.st[1] = nx; }
        const unsigned old = xb_add(&bar[XB_XSUB(b.x)], 1u);
        const unsigned gen = old / nloc;
        if (old + 1u == (gen + 1u) * nloc) {
            __builtin_amdgcn_fence(__ATOMIC_RELEASE, "agent");
            asm volatile("s_waitcnt vmcnt(0)" ::: "memory");
            const unsigned og = xb_add(&bar[XB_TOP], 1u);
            const unsigned tg = og / nx;
            if (og + 1u == (tg + 1u) * nx) xb_add(&bar[XB_TOPGEN], 1u);
            else XB_SPIN(xb_ld(&bar[XB_TOPGEN]) == tg, bar);
            __builtin_amdgcn_fence(__ATOMIC_ACQUIRE, "agent");
            xb_add(&bar[XB_XGEN(b.x)], 1u);
            asm volatile("s_waitcnt vmcnt(0)" ::: "memory");
        } else {
            XB_SPIN(xb_ld(&bar[XB_XGEN(b.x)]) == gen, bar);
            __builtin_amdgcn_fence(__ATOMIC_ACQUIRE, "agent");
            asm volatile("s_waitcnt vmcnt(0)" ::: "memory");
        }
    }
    __syncthreads();
}

struct Frame {
    LAS unsigned char* lds;
    int tid, lane, wave, G, gw, ngw;
};

struct RowId { DI int operator()(int n) const { return n; } };
struct RowGU { int hid; DI int operator()(int n) const { const int up = n >= hid ? 1 : 0, h = n - up * hid; return ((h >> 7) << 8) + (up << 7) + (h & 127); } };
template <bool FP8, class RowMap>
DI void convert_matrix_t(const Frame& F, const float* W, int K, int N, int ldn, void* WTv, int ldk, const RowMap& rm, int nbatch, size_t wstride, size_t tstride) {
    LAS float* scr = (LAS float*)(F.lds + F.wave * 16384);
    const int lane = F.lane, nblk = N / 32, per = (K / 64) * nblk, total = per * nbatch;
    f32x4 v[8];
#define CV_LOAD(it_) do { const int b_ = (it_) / per, r_ = (it_) % per; const float* src_ = W + (size_t)b_ * wstride + (size_t)(64 * (r_ / nblk) + (lane >> 3)) * ldn + 32 * (r_ % nblk) + 4 * (lane & 7); \
        _Pragma("unroll") for (int i = 0; i < 8; ++i) v[i] = *(const f32x4*)(src_ + (size_t)(8 * i) * ldn); } while (0)
    int it = F.gw;
    if (it < total) CV_LOAD(it);
    for (; it < total; it += F.ngw) {
        const int bb = it / per, r = it % per, k0 = 64 * (r / nblk), n0 = 32 * (r % nblk);
        { LAS float* dst = scr + (lane >> 3) * 33 + 4 * (lane & 7);
#pragma unroll
          for (int i = 0; i < 8; ++i) { dst[(8 * i) * 33 + 0] = v[i][0]; dst[(8 * i) * 33 + 1] = v[i][1]; dst[(8 * i) * 33 + 2] = v[i][2]; dst[(8 * i) * 33 + 3] = v[i][3]; } }
        asm volatile("" ::: "memory");
        if (it + F.ngw < total) CV_LOAD(it + F.ngw);
        LDS_WAIT(); asm volatile("" ::: "memory");
        const int c = lane & 7;
#pragma unroll
        for (int j = 0; j < 4; ++j) { const int n = (lane >> 3) + 8 * j; const LAS float* s = scr + (8 * c) * 33 + n;
            if constexpr (FP8) { u32x2 o; o.x = cvt4_fp8(s[0 * 33] * W8_SCALE, s[1 * 33] * W8_SCALE, s[2 * 33] * W8_SCALE, s[3 * 33] * W8_SCALE); o.y = cvt4_fp8(s[4 * 33] * W8_SCALE, s[5 * 33] * W8_SCALE, s[6 * 33] * W8_SCALE, s[7 * 33] * W8_SCALE);
                *(u32x2*)((unsigned char*)WTv + (size_t)bb * tstride + (size_t)rm(n0 + n) * ldk + k0 + 8 * c) = o; }
            else { u32x4 o; o.x = cvt_pk_bf16(s[0 * 33], s[1 * 33]); o.y = cvt_pk_bf16(s[2 * 33], s[3 * 33]); o.z = cvt_pk_bf16(s[4 * 33], s[5 * 33]); o.w = cvt_pk_bf16(s[6 * 33], s[7 * 33]);
                *(u32x4*)((bf16_t*)WTv + (size_t)bb * tstride + (size_t)rm(n0 + n) * ldk + k0 + 8 * c) = o; } }
        LDS_WAIT(); asm volatile("" ::: "memory");
    }
#undef CV_LOAD
}
template <class RowMap>
DI void convert_matrix(const Frame& F, const float* W, int K, int N, int ldn, bf16_t* WT, int ldk, const RowMap& rm, int nbatch, size_t wstride, size_t tstride) { convert_matrix_t<false>(F, W, K, N, ldn, WT, ldk, rm, nbatch, wstride, tstride); }
template <class RowMap>
DI void convert_matrix8(const Frame& F, const float* W, int K, int N, int ldn, unsigned char* WT, int ldk, const RowMap& rm, int nbatch, size_t wstride, size_t tstride) { convert_matrix_t<true>(F, W, K, N, ldn, WT, ldk, rm, nbatch, wstride, tstride); }

DI void load_row(const float* xrow, int lane, f32x4 (&v)[4]) {
#pragma unroll
    for (int j = 0; j < 4; ++j) v[j] = *(const f32x4*)(xrow + 4 * lane + 256 * j);
}
DI void load_row(const bf16_t* xrow, int lane, f32x4 (&v)[4]) {
#pragma unroll
    for (int j = 0; j < 4; ++j) { const u32x2 w = *(const u32x2*)(xrow + 4 * lane + 256 * j); v[j] = (f32x4){bf_lo(w.x), bf_hi(w.x), bf_lo(w.y), bf_hi(w.y)}; }
}
DI float row_rstd(const f32x4 (&v)[4]) {
    float s = 0.f;
#pragma unroll
    for (int j = 0; j < 4; ++j) s += (v[j][0] * v[j][0] + v[j][1] * v[j][1]) + (v[j][2] * v[j][2] + v[j][3] * v[j][3]);
    return rsqrtf(wave_sum(s) * (1.f / D) + EPS);
}
template <bool FP8 = false>
DI void norm_phase(const Frame& F, const bf16_t* X, const float* gain, bf16_t* XN) {
    f32x4 gv[4]; load_row(gain, F.lane, gv);
    f32x4 vn[4]; if (F.gw < T) load_row(X + (size_t)F.gw * D, F.lane, vn);
    for (int t = F.gw; t < T; t += F.ngw) {
        f32x4 v[4];
#pragma unroll
        for (int j = 0; j < 4; ++j) v[j] = vn[j];
        if (t + F.ngw < T) load_row(X + (size_t)(t + F.ngw) * D, F.lane, vn);
        const float rs = row_rstd(v);
#pragma unroll
        for (int j = 0; j < 4; ++j) {
            if constexpr (FP8) { *(unsigned*)((unsigned char*)XN + (size_t)t * D + 4 * F.lane + 256 * j) = cvt4_fp8(v[j][0] * rs * gv[j][0], v[j][1] * rs * gv[j][1], v[j][2] * rs * gv[j][2], v[j][3] * rs * gv[j][3]); }
            else { u32x2 w; w.x = cvt_pk_bf16(v[j][0] * rs * gv[j][0], v[j][1] * rs * gv[j][1]); w.y = cvt_pk_bf16(v[j][2] * rs * gv[j][2], v[j][3] * rs * gv[j][3]);
                *(u32x2*)(XN + (size_t)t * D + 4 * F.lane + 256 * j) = w; } }
    }
}
template <class XT>
DI void norm_to_ug_phase(const Frame& F, const XT* X, const float* gain, bf16_t* UG, bf16_t* XB) {
    f32x4 gv[4];
#pragma unroll
    for (int j = 0; j < 4; ++j) gv[j] = *(const f32x4*)(gain + 16 * F.lane + 4 * j);
    constexpr int NCH = T / S5C, TS = 2080;
    LAS unsigned char* st = F.lds;
    for (int ch = blockIdx.x; ch < NCH; ch += F.G) {
        f32x4 v[4][4];
#pragma unroll
        for (int i = 0; i < 4; ++i)
#pragma unroll
            for (int j = 0; j < 4; ++j) { const XT* src = X + (size_t)(ch * S5C + 4 * F.wave + i) * D + 16 * F.lane + 4 * j;
                if constexpr (sizeof(XT) == 4) v[i][j] = *(const f32x4*)src; else { const u32x2 w = *(const u32x2*)src; v[i][j] = (f32x4){bf_lo(w.x), bf_hi(w.x), bf_lo(w.y), bf_hi(w.y)}; } }
#pragma unroll
        for (int i = 0; i < 4; ++i) { const float rs = row_rstd(v[i]); unsigned w[8];
#pragma unroll
            for (int j = 0; j < 4; ++j) { w[2 * j] = cvt_pk_bf16(v[i][j][0] * rs * gv[j][0], v[i][j][1] * rs * gv[j][1]); w[2 * j + 1] = cvt_pk_bf16(v[i][j][2] * rs * gv[j][2], v[i][j][3] * rs * gv[j][3]); }
            if constexpr (sizeof(XT) == 4) { bf16_t* xb = XB + (size_t)(ch * S5C + 4 * F.wave + i) * D + 16 * F.lane;
                *(u32x4*)xb = (u32x4){cvt_pk_bf16(v[i][0][0], v[i][0][1]), cvt_pk_bf16(v[i][0][2], v[i][0][3]), cvt_pk_bf16(v[i][1][0], v[i][1][1]), cvt_pk_bf16(v[i][1][2], v[i][1][3])};
                *(u32x4*)(xb + 8) = (u32x4){cvt_pk_bf16(v[i][2][0], v[i][2][1]), cvt_pk_bf16(v[i][2][2], v[i][2][3]), cvt_pk_bf16(v[i][3][0], v[i][3][1]), cvt_pk_bf16(v[i][3][2], v[i][3][3])}; }
            LAS unsigned char* dl = st + (4 * F.wave + i) * TS + F.lane * 32;
            *(LAS u32x4*)dl = (u32x4){w[0], w[1], w[2], w[3]}; *(LAS u32x4*)(dl + 16) = (u32x4){w[4], w[5], w[6], w[7]}; }
        __syncthreads();
#pragma unroll
        for (int k = 0; k < 8; ++k) { const int g = 8 * F.wave + k;
            const u32x4 o = *(const LAS u32x4*)(st + (F.lane >> 1) * TS + g * 32 + (F.lane & 1) * 16);
            *(u32x4*)(UG + ((size_t)g * S5ROWS + ch) * S5LD + 8 * F.lane) = o; }
        __syncthreads();
    }
}

struct S5P { const float *lam_re, *lam_im, *log_dt, *b_re, *b_im, *c_re, *c_im, *dskip, *w_glu, *b_glu; };
DI void s5_tables_phase(const Frame& F, const S5P& p, bf16_t* TG, bf16_t* FG) {
    LAS f32x2* pw = (LAS f32x2*)(F.lds);
    LAS f32x2* bb = (LAS f32x2*)(F.lds + 16896);
    LAS f32x2* cc = (LAS f32x2*)(F.lds + 25088);
    LAS float* kt = (LAS float*)(F.lds + 33280);
    LAS f32x2* cct = (LAS f32x2*)(F.lds + 67584);
    const int tid = F.tid;
    for (int unit = blockIdx.x; unit < 256; unit += F.G) {
        const int g = unit >> 2, q = unit & 3;
        const float dt = expf(p.log_dt[g]);
        for (int i = tid; i < 33 * 64; i += NTHR) { const int tau = i >> 6, pp = i & 63; const float lre = p.lam_re[g * 64 + pp], lim = p.lam_im[g * 64 + pp];
            const float mag = __expf((float)tau * dt * lre), rev = __builtin_amdgcn_fractf((float)tau * (dt * lim * 0.15915494309189535f)); pw[i] = (f32x2){mag * __builtin_amdgcn_cosf(rev), mag * __builtin_amdgcn_sinf(rev)}; }
        for (int i = tid; i < 1024; i += NTHR) { const int pp = i >> 4, hi = i & 15; const float lre = p.lam_re[g * 64 + pp], lim = p.lam_im[g * 64 + pp];
            const float mag = __expf(dt * lre), rev = __builtin_amdgcn_fractf(dt * lim * 0.15915494309189535f), nr = mag * __builtin_amdgcn_cosf(rev) - 1.f, ni = mag * __builtin_amdgcn_sinf(rev), den = __builtin_amdgcn_rcpf(lre * lre + lim * lim);
            const float cr = (nr * lre + ni * lim) * den, ci = (ni * lre - nr * lim) * den;
            const float br = p.b_re[(size_t)(g * 64 + pp) * 16 + hi], bi = p.b_im[(size_t)(g * 64 + pp) * 16 + hi];
            bb[i] = (f32x2){cr * br - ci * bi, cr * bi + ci * br}; }
        for (int i = tid; i < 1024; i += NTHR) { const int ho = i >> 6, pp = i & 63; const f32x2 cv = (f32x2){p.c_re[(size_t)(g * 16 + ho) * 64 + pp], p.c_im[(size_t)(g * 16 + ho) * 64 + pp]}; cc[i] = cv; cct[pp * 16 + ho] = cv; }
        __syncthreads();
        {
          const int tau = tid >> 4, ho0 = ((tid >> 2) & 3) * 4, hi0 = (tid & 3) * 4;
          float acc[4][4];
#pragma unroll
          for (int i = 0; i < 4; ++i)
#pragma unroll
              for (int j = 0; j < 4; ++j) acc[i][j] = 0.f;
#pragma unroll 2
          for (int pp = 0; pp < 64; ++pp) { const f32x2 a = pw[tau * 64 + pp];
              const f32x4 b01 = *(const LAS f32x4*)(bb + pp * 16 + hi0), b23 = *(const LAS f32x4*)(bb + pp * 16 + hi0 + 2);
              const float br[4] = {b01[0], b01[2], b23[0], b23[2]}, bi[4] = {b01[1], b01[3], b23[1], b23[3]};
              const f32x4 c01 = *(const LAS f32x4*)(cct + pp * 16 + ho0), c23 = *(const LAS f32x4*)(cct + pp * 16 + ho0 + 2);
              const float cr[4] = {c01[0], c01[2], c23[0], c23[2]}, ci[4] = {c01[1], c01[3], c23[1], c23[3]};
#pragma unroll
              for (int i = 0; i < 4; ++i) { const float zr = cr[i] * a.x - ci[i] * a.y, zi = cr[i] * a.y + ci[i] * a.x;
#pragma unroll
                  for (int j = 0; j < 4; ++j) acc[i][j] += zr * br[j] - zi * bi[j]; } }
          if (tau == 0 && ho0 == hi0) {
#pragma unroll
              for (int i = 0; i < 4; ++i) acc[i][i] += p.dskip[g * 16 + ho0 + i]; }
#pragma unroll
          for (int i = 0; i < 4; ++i) *(LAS f32x4*)(kt + tau * 264 + (ho0 + i) * 16 + hi0) = (f32x4){acc[i][0], acc[i][1], acc[i][2], acc[i][3]}; }
        __syncthreads();
        for (int nl = F.wave; nl < 128; nl += NWAVES) for (int ck = F.lane; ck < 80; ck += 64) { const int n = 128 * q + nl, l = n >> 4, ho = n & 15, k0 = 8 * ck; float v[8];
            if (k0 < S5K) { const int lp = k0 >> 4, hi0 = k0 & 15;
#pragma unroll
                for (int j = 0; j < 8; ++j) v[j] = (lp <= l) ? kt[(l - lp) * 264 + ho * 16 + hi0 + j] : 0.f; }
            else if (k0 < S5K + 64) { const int p0 = k0 - S5K;
#pragma unroll
                for (int j = 0; j < 8; ++j) { const f32x2 c = cc[ho * 64 + p0 + j], a = pw[(l + 1) * 64 + p0 + j]; v[j] = c.x * a.x - c.y * a.y; } }
            else { const int p0 = k0 - S5K - 64;
#pragma unroll
                for (int j = 0; j < 8; ++j) { const f32x2 c = cc[ho * 64 + p0 + j], a = pw[(l + 1) * 64 + p0 + j]; v[j] = -(c.x * a.y + c.y * a.x); } }
            *(u32x4*)(TG + ((size_t)g * S5K + n) * S5LD + k0) = (u32x4){cvt_pk_bf16(v[0], v[1]), cvt_pk_bf16(v[2], v[3]), cvt_pk_bf16(v[4], v[5]), cvt_pk_bf16(v[6], v[7])}; }
        for (int ch = tid; ch < 32 * 64; ch += NTHR) { const int nl = ch >> 6, ck = ch & 63, n = 32 * q + nl, pp = n & 63, k0 = 8 * ck, lp = k0 >> 4, hi0 = k0 & 15, tau = S5C - 1 - lp; float v[8];
            const f32x2 a = pw[tau * 64 + pp];
#pragma unroll
            for (int j = 0; j < 8; ++j) { const f32x2 b = bb[pp * 16 + hi0 + j]; v[j] = (n < 64) ? (a.x * b.x - a.y * b.y) : (a.x * b.y + a.y * b.x); }
            *(u32x4*)(FG + ((size_t)g * 256 + n) * S5K + k0) = (u32x4){cvt_pk_bf16(v[0], v[1]), cvt_pk_bf16(v[2], v[3]), cvt_pk_bf16(v[4], v[5]), cvt_pk_bf16(v[6], v[7])}; }
        __syncthreads();
    }
}
DI void s5_scan_tile(const Frame& F, const S5P& p, const float* SLOC, bf16_t* UG, int g, int pm) {
    if (F.tid < 256) {
        const int pp = F.tid & 63, b = 4 * pm + (F.tid >> 6);
        const float dt = expf(p.log_dt[g]), lre = p.lam_re[g * 64 + pp], lim = p.lam_im[g * 64 + pp];
        const float mag = __expf((float)S5C * dt * lre), rev = __builtin_amdgcn_fractf((float)S5C * (dt * lim * 0.15915494309189535f)), ar = mag * __builtin_amdgcn_cosf(rev), ai = mag * __builtin_amdgcn_sinf(rev);
        float sr = 0.f, si = 0.f;
        const int nch = SEQ / S5C;
#pragma unroll 16
        for (int c = 0; c < nch; ++c) { const size_t R = (size_t)g * S5ROWS + b * nch + c;
            UG[R * S5LD + S5K + pp] = f2bf(sr); UG[R * S5LD + S5K + 64 + pp] = f2bf(si);
            const float lr = SLOC[R * 128 + pp], li = SLOC[R * 128 + 64 + pp];
            const float nr = ar * sr - ai * si + lr, ni = ar * si + ai * sr + li; sr = nr; si = ni; }
    }
}
DI void s5_scan_phase(const Frame& F, const S5P& p, const float* SLOC, bf16_t* UG) {
    const int gt = blockIdx.x * NTHR + F.tid, nth = F.G * NTHR;
    for (int id = gt; id < 64 * BATCH * 64; id += nth) {
        const int pp = id & 63, b = (id >> 6) & 15, g = id >> 10;
        const float dt = expf(p.log_dt[g]), lre = p.lam_re[g * 64 + pp], lim = p.lam_im[g * 64 + pp];
        const float mag = __expf((float)S5C * dt * lre), rev = __builtin_amdgcn_fractf((float)S5C * (dt * lim * 0.15915494309189535f)), ar = mag * __builtin_amdgcn_cosf(rev), ai = mag * __builtin_amdgcn_sinf(rev);
        float sr = 0.f, si = 0.f;
        const int nch = SEQ / S5C;
#pragma unroll 16
        for (int c = 0; c < nch; ++c) { const size_t R = (size_t)g * S5ROWS + b * nch + c;
            UG[R * S5LD + S5K + pp] = f2bf(sr); UG[R * S5LD + S5K + 64 + pp] = f2bf(si);
            const float lr = SLOC[R * 128 + pp], li = SLOC[R * 128 + 64 + pp];
            const float nr = ar * sr - ai * si + lr, ni = ar * si + ai * sr + li; sr = nr; si = ni; }
    }
}

DI void gla_prep_phase(const Frame& F, const bf16_t* PROJ, const float* wg2, const float* bg2, bf16_t* QSB, bf16_t* KE, bf16_t* SCB, float* DECG) {
    constexpr int QS = 0, KS = 17408, KET = 34816, SC = 53248, VT = 62464, GLOW = 99328, WG2 = 103424, QSUM = 111616, BG = 113664;
    LAS unsigned char* lds = F.lds;
    const int tid = F.tid, lane = F.lane, w = F.wave, q4 = lane >> 4, r16 = lane & 15;
    const int d = tid & 127, tq = __builtin_amdgcn_readfirstlane(tid >> 7);
    int hprev = -1;
    u32x4 pq[2], pk[2], pg; pg = (u32x4){0u, 0u, 0u, 0u};
#define GLP_ISSUE(uu) do { const int h_ = (uu) & 3; const size_t tk0 = (size_t)((uu) >> 7) * SEQ + (((uu) >> 2) & 31) * 64; \
        _Pragma("unroll") for (int i = 0; i < 2; ++i) { const int id = tid + NTHR * i; const bf16_t* src = PROJ + (tk0 + (id >> 4)) * GLA_N + h_ * 128 + (id & 15) * 8; pq[i] = *(const u32x4*)src; pk[i] = *(const u32x4*)(src + 512); } \
        if (tid < 128) pg = *(const u32x4*)(PROJ + (tk0 + (tid >> 1)) * GLA_N + 3072 + (tid & 1) * 8); } while (0)
    if ((int)blockIdx.x < 2048) GLP_ISSUE((int)blockIdx.x);
    for (int u = blockIdx.x; u < 2048; u += F.G) {
        const int h = u & 3;
        if (h != hprev) { for (int i = tid; i < 2048; i += NTHR) ((LAS float*)(lds + WG2))[i] = wg2[(i >> 7) * 512 + h * 128 + (i & 127)];
            if (tid < 128) ((LAS float*)(lds + BG))[tid] = bg2[h * 128 + tid]; hprev = h; }
#pragma unroll
        for (int i = 0; i < 2; ++i) { const int id = tid + NTHR * i, row = id >> 4, c8 = id & 15; *(LAS u32x4*)(lds + QS + row * 272 + c8 * 16) = pq[i]; *(LAS u32x4*)(lds + KS + row * 272 + c8 * 16) = pk[i]; }
        if (tid < 128) { const int row = tid >> 1, hf = tid & 1; LAS float* gl = (LAS float*)(lds + GLOW) + row * 16 + hf * 8;
            gl[0] = bf_lo(pg.x); gl[1] = bf_hi(pg.x); gl[2] = bf_lo(pg.y); gl[3] = bf_hi(pg.y); gl[4] = bf_lo(pg.z); gl[5] = bf_hi(pg.z); gl[6] = bf_lo(pg.w); gl[7] = bf_hi(pg.w); }
        LDS_BARRIER();
        if (u + F.G < 2048) GLP_ISSUE(u + F.G);
        float cum[16];
        { float wcol[16];
#pragma unroll
          for (int r = 0; r < 16; ++r) wcol[r] = ((LAS float*)(lds + WG2))[r * 128 + d];
          const float bcol = ((LAS float*)(lds + BG))[d]; float run = 0.f;
#pragma unroll
          for (int i = 0; i < 16; ++i) { const LAS f32x4* gl = (const LAS f32x4*)(lds + GLOW + (tq * 16 + i) * 64); float z = bcol;
#pragma unroll
              for (int r4 = 0; r4 < 4; ++r4) { const f32x4 gq = gl[r4]; z += gq[0] * wcol[4 * r4] + gq[1] * wcol[4 * r4 + 1] + gq[2] * wcol[4 * r4 + 2] + gq[3] * wcol[4 * r4 + 3]; }
              const float ls = fminf(z, 0.f) - __logf(1.f + __expf(-fabsf(z))); run += ls * (1.f / 16.f); cum[i] = run; }
          ((LAS float*)(lds + QSUM))[tq * 128 + d] = run; }
        LDS_BARRIER();
        { float off = 0.f, glast = 0.f;
#pragma unroll
          for (int t4 = 0; t4 < 4; ++t4) { const float qv = ((LAS float*)(lds + QSUM))[t4 * 128 + d]; glast += qv; if (t4 < tq) off += qv; }
          const float dec = __expf(glast);
          unsigned ke[8];
#pragma unroll
          for (int i = 0; i < 16; i += 2) { float kend[2];
#pragma unroll
              for (int ii = 0; ii < 2; ++ii) { const int tok = tq * 16 + i + ii; const float eg = __expf(off + cum[i + ii]), eng = __builtin_amdgcn_rcpf(eg);
                  LAS bf16_t* qp = (LAS bf16_t*)(lds + QS + tok * 272 + d * 2); LAS bf16_t* kp = (LAS bf16_t*)(lds + KS + tok * 272 + d * 2);
                  const float qv = bf2f(*qp), ks = bf2f(*kp) * eng;
                  *qp = f2bf(qv * 0.08838834764831845f * eg); *kp = f2bf(ks); kend[ii] = ks * dec; }
              ke[i >> 1] = cvt_pk_bf16(kend[0], kend[1]); }
          *(LAS u32x4*)(lds + KET + d * 144 + tq * 32) = (u32x4){ke[0], ke[1], ke[2], ke[3]}; *(LAS u32x4*)(lds + KET + d * 144 + tq * 32 + 16) = (u32x4){ke[4], ke[5], ke[6], ke[7]};
          if (tq == 0) DECG[(size_t)u * 128 + d] = dec; }
        LDS_BARRIER();
        { const int it = w >> 1;
#pragma unroll
          for (int jj = 0; jj < 2; ++jj) { const int jt = 2 * (w & 1) + jj; f32x4 a = (f32x4){0.f, 0.f, 0.f, 0.f};
              if (jt <= it) {
#pragma unroll
                  for (int ks = 0; ks < 4; ++ks) { const bf16x8 af = *(const LAS bf16x8*)(lds + QS + (16 * it + r16) * 272 + (ks * 32 + q4 * 8) * 2), bfr = *(const LAS bf16x8*)(lds + KS + (16 * jt + r16) * 272 + (ks * 32 + q4 * 8) * 2);
                      a = __builtin_amdgcn_mfma_f32_16x16x32_bf16(af, bfr, a, 0, 0, 0); } }
#pragma unroll
              for (int rr = 0; rr < 4; ++rr) { const int i = 16 * it + 4 * q4 + rr, j = 16 * jt + r16; *(LAS bf16_t*)(lds + SC + i * 144 + j * 2) = f2bf(j <= i ? a[rr] : 0.f); } } }
        LDS_BARRIER();
#pragma unroll
        for (int i = 0; i < 2; ++i) { const int id = tid + NTHR * i, row = id >> 4, c8 = id & 15; *(u32x4*)(QSB + (size_t)u * 8192 + (size_t)id * 8) = *(const LAS u32x4*)(lds + QS + row * 272 + c8 * 16); }
#pragma unroll
        for (int i = 0; i < 2; ++i) { const int id = tid + NTHR * i, row = id >> 3, c8 = id & 7; *(u32x4*)(KE + (size_t)u * 8192 + (size_t)id * 8) = *(const LAS u32x4*)(lds + KET + row * 144 + c8 * 16); }
        { const int row = tid >> 3, c8 = tid & 7; *(u32x4*)(SCB + (size_t)u * 4096 + (size_t)tid * 8) = *(const LAS u32x4*)(lds + SC + row * 144 + c8 * 16); }
        LDS_BARRIER();
    }
#undef GLP_ISSUE
}
DI void gla_seq_phase(const Frame& F, const bf16_t* QSB, const bf16_t* KE, const bf16_t* SCB, const bf16_t* PROJ, const float* DECG, bf16_t* GO) {
    constexpr int BUF = 54784, QS = 0, KET = 17408, VT = 35840, SC = 45056, DEC = 54272, ST0 = 2 * BUF, STB = 17408;
    LAS unsigned char* lds = F.lds;
    const int tid = F.tid, lane = F.lane, w = F.wave, q4 = lane >> 4, r16 = lane & 15;
    const int vtb = (8 * q4 + ((lane >> 2) & 3)) * 144 + (lane & 3) * 8;
    for (int ui = blockIdx.x; ui < 256; ui += F.G) {
        const int unit = (F.G == 256) ? (((ui & 7) << 5) | (ui >> 3)) : ui;
        const int b = unit >> 4, h = (unit >> 2) & 3, s = unit & 3;
        for (int i = tid; i < STB / 4; i += NTHR) ((LAS unsigned*)(lds + ST0))[i] = 0u;
        f32x4 st[4];
#pragma unroll
        for (int e = 0; e < 4; ++e) st[e] = (f32x4){0.f, 0.f, 0.f, 0.f};
        u32x4 rA[7], rB[7];
        rA[6] = (u32x4){0u, 0u, 0u, 0u}; rB[6] = (u32x4){0u, 0u, 0u, 0u};
#define GLA_ISSUE(R, nn) do { const size_t uu = (size_t)b * 128 + (nn) * 4 + h; \
            _Pragma("unroll") for (int i = 0; i < 2; ++i) { const int id = tid + NTHR * i; R[i] = *(const u32x4*)(QSB + uu * 8192 + (size_t)id * 8); R[2 + i] = *(const u32x4*)(KE + uu * 8192 + (size_t)id * 8); } \
            R[4] = *(const u32x4*)(PROJ + ((size_t)b * SEQ + (nn) * 64 + (tid >> 3)) * GLA_N + 1024 + h * 256 + s * 64 + (tid & 7) * 8); R[5] = *(const u32x4*)(SCB + uu * 4096 + (size_t)tid * 8); \
            if (tid < 32) R[6] = *(const u32x4*)(DECG + uu * 128 + tid * 4); } while (0)
#define GLA_TO_LDS(R, bufb) do { _Pragma("unroll") for (int i = 0; i < 2; ++i) { const int id = tid + NTHR * i; *(LAS u32x4*)((bufb) + QS + (id >> 4) * 272 + (id & 15) * 16) = R[i]; *(LAS u32x4*)((bufb) + KET + (id >> 3) * 144 + (id & 7) * 16) = R[2 + i]; } \
            *(LAS u32x4*)((bufb) + VT + (tid >> 3) * 144 + (tid & 7) * 16) = R[4]; *(LAS u32x4*)((bufb) + SC + (tid >> 3) * 144 + (tid & 7) * 16) = R[5]; \
            if (tid < 32) *(LAS u32x4*)((bufb) + DEC + tid * 16) = R[6]; } while (0)
#define GLA_VTR(bufb_, et_, ks_) __builtin_shufflevector(__builtin_amdgcn_ds_read_tr16_b64_v4i16((LAS s16x4*)((bufb_) + VT + vtb + (ks_) * (32 * 144) + (et_) * 32)), \
            __builtin_amdgcn_ds_read_tr16_b64_v4i16((LAS s16x4*)((bufb_) + VT + vtb + (ks_) * (32 * 144) + (et_) * 32 + 4 * 144)), 0, 1, 2, 3, 4, 5, 6, 7)
#define GLA_STEP(n) do { const size_t tok0 = (size_t)b * SEQ + (n) * 64; \
            const LAS unsigned char* bufb = lds + ((n) & 1) * BUF; const LAS unsigned char* stc = lds + ST0 + ((n) & 1) * STB; LAS unsigned char* stn = lds + ST0 + (((n) + 1) & 1) * STB; \
            const int fo = q4 * 16; \
            { const int tt = w >> 1; bf16x8 bs[2], bq[4]; \
              _Pragma("unroll") for (int ks = 0; ks < 2; ++ks) bs[ks] = *(const LAS bf16x8*)(bufb + SC + (16 * tt + r16) * 144 + ks * 64 + fo); \
              _Pragma("unroll") for (int ks = 0; ks < 4; ++ks) bq[ks] = *(const LAS bf16x8*)(bufb + QS + (16 * tt + r16) * 272 + ks * 64 + fo); \
              _Pragma("unroll") for (int ee = 0; ee < 2; ++ee) { const int et = 2 * (w & 1) + ee; f32x4 a = (f32x4){0.f, 0.f, 0.f, 0.f}; \
                  _Pragma("unroll") for (int ks = 0; ks < 2; ++ks) { const bf16x8 av = GLA_VTR(bufb, et, ks); a = __builtin_amdgcn_mfma_f32_16x16x32_bf16(av, bs[ks], a, 0, 0, 0); } \
                  _Pragma("unroll") for (int ks = 0; ks < 4; ++ks) { const bf16x8 as = *(const LAS bf16x8*)(stc + (16 * et + r16) * 272 + ks * 64 + fo); a = __builtin_amdgcn_mfma_f32_16x16x32_bf16(as, bq[ks], a, 0, 0, 0); } \
                  *(u32x2*)(GO + (tok0 + 16 * tt + r16) * D + h * 256 + s * 64 + 16 * et + 4 * q4) = (u32x2){cvt_pk_bf16(a[0], a[1]), cvt_pk_bf16(a[2], a[3])}; } } \
            { bf16x8 ak[2]; \
              _Pragma("unroll") for (int ks = 0; ks < 2; ++ks) ak[ks] = *(const LAS bf16x8*)(bufb + KET + (16 * w + r16) * 144 + ks * 64 + fo); \
              const f32x4 dec = *(const LAS f32x4*)(bufb + DEC + (16 * w + 4 * q4) * 4); \
              _Pragma("unroll") for (int et = 0; et < 4; ++et) { st[et] = st[et] * dec; \
                  _Pragma("unroll") for (int ks = 0; ks < 2; ++ks) { const bf16x8 bv = GLA_VTR(bufb, et, ks); st[et] = __builtin_amdgcn_mfma_f32_16x16x32_bf16(ak[ks], bv, st[et], 0, 0, 0); } \
                  *(LAS u32x2*)(stn + (16 * et + r16) * 272 + (16 * w + 4 * q4) * 2) = (u32x2){cvt_pk_bf16(st[et][0], st[et][1]), cvt_pk_bf16(st[et][2], st[et][3])}; } } } while (0)
        GLA_ISSUE(rA, 0); GLA_ISSUE(rB, 1); GLA_TO_LDS(rA, lds); GLA_ISSUE(rA, 2);
        LDS_BARRIER();
        for (int n = 0; n < 32; n += 2) {
            asm volatile("" ::: "memory");
            GLA_STEP(n);
            GLA_TO_LDS(rB, lds + BUF);
            if (n + 3 < 32) GLA_ISSUE(rB, n + 3);
            LDS_BARRIER();
            asm volatile("" ::: "memory");
            GLA_STEP(n + 1);
            if (n + 2 < 32) { GLA_TO_LDS(rA, lds); }
            if (n + 4 < 32) GLA_ISSUE(rA, n + 4);
            LDS_BARRIER();
        }
#undef GLA_ISSUE
#undef GLA_TO_LDS
#undef GLA_STEP
#undef GLA_VTR
    }
}
DI void gla_finalize_phase(const Frame& F, const bf16_t* GO, const bf16_t* PROJ, const float* gnorm, bf16_t* OG) {
    f32x4 gv[4];
#pragma unroll
    for (int j = 0; j < 4; ++j) gv[j] = *(const f32x4*)(gnorm + 16 * F.lane + 4 * j);
    for (int t = F.gw; t < T; t += F.ngw) {
        const u32x4 o0 = *(const u32x4*)(GO + (size_t)t * D + 16 * F.lane), o1 = *(const u32x4*)(GO + (size_t)t * D + 16 * F.lane + 8);
        const u32x4 r0 = *(const u32x4*)(PROJ + (size_t)t * GLA_N + 2048 + 16 * F.lane), r1 = *(const u32x4*)(PROJ + (size_t)t * GLA_N + 2048 + 16 * F.lane + 8);
        const unsigned ow[8] = {o0.x, o0.y, o0.z, o0.w, o1.x, o1.y, o1.z, o1.w}, rw[8] = {r0.x, r0.y, r0.z, r0.w, r1.x, r1.y, r1.z, r1.w};
        float o[16], ss = 0.f;
#pragma unroll
        for (int j = 0; j < 8; ++j) { o[2 * j] = bf_lo(ow[j]); o[2 * j + 1] = bf_hi(ow[j]); ss += o[2 * j] * o[2 * j] + o[2 * j + 1] * o[2 * j + 1]; }
        ss += __shfl_xor(ss, 1); ss += __shfl_xor(ss, 2); ss += __shfl_xor(ss, 4); ss += __shfl_xor(ss, 8);
        const float rs = rsqrtf(ss * (1.f / 256.f) + EPS);
        unsigned w[8];
#pragma unroll
        for (int j = 0; j < 8; ++j) { const float ra = bf_lo(rw[j]), rb = bf_hi(rw[j]); w[j] = cvt_pk_bf16(o[2 * j] * rs * gv[j >> 1][(2 * j) & 3] * silu_f(ra), o[2 * j + 1] * rs * gv[j >> 1][(2 * j + 1) & 3] * silu_f(rb)); }
        *(u32x4*)(OG + (size_t)t * D + 16 * F.lane) = (u32x4){w[0], w[1], w[2], w[3]}; *(u32x4*)(OG + (size_t)t * D + 16 * F.lane + 8) = (u32x4){w[4], w[5], w[6], w[7]};
    }
}

DI void swa_phase(const Frame& F, const bf16_t* QKV, const float* sinks, bf16_t* AO) {
    constexpr int KB = 0, VT = 36864;
    constexpr float L2E = 1.4426950408889634f;
    LAS unsigned char* lds = F.lds;
    const int tid = F.tid, lane = F.lane, w = F.wave, q4 = lane >> 4, r16 = lane & 15;
    const LAS unsigned char* kbase = lds + KB + (16 * w + r16) * 144 + q4 * 16;
    const LAS unsigned char* vbase = lds + VT + r16 * 528 + (16 * w + 4 * q4) * 2;
    LAS float* sinkl = (LAS float*)(lds + 70656);
    if (tid < 16) sinkl[tid] = sinks[tid];
    for (int unit = blockIdx.x; unit < 512; unit += F.G) {
        const int kh = unit & 1, n = (unit >> 1) & 15, b = unit >> 5;
        const long tokq0 = (long)b * SEQ + n * 128, tokk0 = tokq0 - 128;
        { const int row0 = tid >> 3, c8 = tid & 7;
          const bf16_t* src0 = QKV + (size_t)(tokk0 + row0) * QKV_N + 1024 + kh * 64 + c8 * 8;
          LAS unsigned char* kdst = lds + KB + row0 * 144 + c8 * 16; LAS unsigned char* vdst = lds + VT + c8 * (8 * 528) + row0 * 2;
#pragma unroll
          for (int i = 0; i < 4; ++i) {
              u32x4 kv = (u32x4){0u, 0u, 0u, 0u}, vv = (u32x4){0u, 0u, 0u, 0u};
              if ((n > 0) || (i >= 2)) { kv = *(const u32x4*)(src0 + (size_t)i * 64 * QKV_N); vv = *(const u32x4*)(src0 + (size_t)i * 64 * QKV_N + 128); }
              *(LAS u32x4*)(kdst + i * 64 * 144) = kv;
              const unsigned wv[4] = {vv.x, vv.y, vv.z, vv.w};
#pragma unroll
              for (int j = 0; j < 4; ++j) { *(LAS bf16_t*)(vdst + (2 * j) * 528 + i * 128) = (bf16_t)(wv[j] & 0xffffu); *(LAS bf16_t*)(vdst + (2 * j + 1) * 528 + i * 128) = (bf16_t)(wv[j] >> 16); } } }
        const size_t qtok = (size_t)(tokq0 + 16 * w + r16);
        const bf16_t* qrow = QKV + qtok * QKV_N + kh * 512 + q4 * 8;
        bf16x8 qn[2][2];
#pragma unroll
        for (int hh = 0; hh < 2; ++hh)
#pragma unroll
            for (int s2 = 0; s2 < 2; ++s2) qn[hh][s2] = *(const bf16x8*)(qrow + hh * 64 + 32 * s2);
        __syncthreads();
        float cm[4];
#pragma unroll
        for (int rr = 0; rr < 4; ++rr) cm[rr] = (float)(r16 - 4 * q4 - rr);
#pragma unroll 1
        for (int gp = 0; gp < 4; ++gp) {
            asm volatile("" ::: "memory");
            bf16x8 qc[2][2];
#pragma unroll
            for (int hh = 0; hh < 2; ++hh)
#pragma unroll
                for (int s2 = 0; s2 < 2; ++s2) qc[hh][s2] = qn[hh][s2];
            if (gp < 3) {
#pragma unroll
                for (int hh = 0; hh < 2; ++hh)
#pragma unroll
                    for (int s2 = 0; s2 < 2; ++s2) qn[hh][s2] = *(const bf16x8*)(qrow + (2 * gp + 2 + hh) * 64 + 32 * s2); }
            f32x4 sc[2][9];
#pragma unroll
            for (int kt = 0; kt < 9; ++kt) { sc[0][kt] = (f32x4){0.f, 0.f, 0.f, 0.f}; sc[1][kt] = (f32x4){0.f, 0.f, 0.f, 0.f};
#pragma unroll
                for (int s2 = 0; s2 < 2; ++s2) { const bf16x8 kf = *(const LAS bf16x8*)(kbase + kt * 2304 + s2 * 64);
                    sc[0][kt] = __builtin_amdgcn_mfma_f32_16x16x32_bf16(kf, qc[0][s2], sc[0][kt], 0, 0, 0); sc[1][kt] = __builtin_amdgcn_mfma_f32_16x16x32_bf16(kf, qc[1][s2], sc[1][kt], 0, 0, 0); } }
            float inv[2];
#pragma unroll
            for (int hh = 0; hh < 2; ++hh) {
                const int hq = kh * 8 + 2 * gp + hh; const float slope2 = exp2f(-0.5f * (float)(hq + 1)) * L2E, sink2 = sinkl[hq] * L2E;
                const f32x2 nb0 = (f32x2){-slope2 * cm[0], -slope2 * cm[1]}, nb1 = (f32x2){-slope2 * cm[2], -slope2 * cm[3]};
                float mx = -1e30f;
#pragma unroll
                for (int kt = 0; kt < 9; ++kt) { const bool tile_ok = (n > 0) || (w + kt >= 8); const float tkn = -slope2 * (float)(128 - 16 * kt);
                    f32x2 v0 = (f32x2){sc[hh][kt][0], sc[hh][kt][1]} * (0.125f * L2E) + (nb0 + tkn), v1 = (f32x2){sc[hh][kt][2], sc[hh][kt][3]} * (0.125f * L2E) + (nb1 + tkn);
                    float vv[4] = {v0.x, v0.y, v1.x, v1.y};
#pragma unroll
                    for (int rr = 0; rr < 4; ++rr) { bool ok = tile_ok; if (kt == 0) ok = ok && (cm[rr] < 0.f); if (kt == 8) ok = ok && (cm[rr] >= 0.f);
                        if (kt == 0 || kt == 8) vv[rr] = ok ? vv[rr] : -1e30f; else vv[rr] = tile_ok ? vv[rr] : -1e30f; sc[hh][kt][rr] = vv[rr]; }
                    mx = fmaxf(mx, fmaxf(fmaxf(vv[0], vv[1]), fmaxf(vv[2], vv[3]))); }
                mx = fmaxf(mx, __shfl_xor(mx, 16)); mx = fmaxf(mx, __shfl_xor(mx, 32)); mx = fmaxf(mx, sink2);
                f32x2 l2 = (f32x2){0.f, 0.f};
#pragma unroll
                for (int kt = 0; kt < 9; ++kt) { const f32x2 d0 = (f32x2){sc[hh][kt][0], sc[hh][kt][1]} - mx, d1 = (f32x2){sc[hh][kt][2], sc[hh][kt][3]} - mx;
                    const f32x2 p0 = (f32x2){__builtin_amdgcn_exp2f(d0.x), __builtin_amdgcn_exp2f(d0.y)}, p1 = (f32x2){__builtin_amdgcn_exp2f(d1.x), __builtin_amdgcn_exp2f(d1.y)};
                    sc[hh][kt] = (f32x4){p0.x, p0.y, p1.x, p1.y}; l2 = l2 + (p0 + p1); }
                float l = l2.x + l2.y;
                l += __shfl_xor(l, 16); l += __shfl_xor(l, 32); l += __builtin_amdgcn_exp2f(sink2 - mx);
                inv[hh] = __builtin_amdgcn_rcpf(l); }
            f32x4 o[2][4];
#pragma unroll
            for (int dt = 0; dt < 4; ++dt) { o[0][dt] = (f32x4){0.f, 0.f, 0.f, 0.f}; o[1][dt] = (f32x4){0.f, 0.f, 0.f, 0.f}; }
#pragma unroll
            for (int c = 0; c < 5; ++c) {
                bf16x8 pf[2];
#pragma unroll
                for (int hh = 0; hh < 2; ++hh) { u32x4 pw4; pw4.x = cvt_pk_bf16(sc[hh][2 * c][0], sc[hh][2 * c][1]); pw4.y = cvt_pk_bf16(sc[hh][2 * c][2], sc[hh][2 * c][3]);
                    if (c < 4) { pw4.z = cvt_pk_bf16(sc[hh][2 * c + 1][0], sc[hh][2 * c + 1][1]); pw4.w = cvt_pk_bf16(sc[hh][2 * c + 1][2], sc[hh][2 * c + 1][3]); } else { pw4.z = 0u; pw4.w = 0u; }
                    pf[hh] = __builtin_bit_cast(bf16x8, pw4); }
#pragma unroll
                for (int dt = 0; dt < 4; ++dt) { const u32x2 vlo = *(const LAS u32x2*)(vbase + dt * 8448 + (2 * c) * 32);
                    u32x2 vhi = (u32x2){0u, 0u}; if (c < 4) vhi = *(const LAS u32x2*)(vbase + dt * 8448 + (2 * c + 1) * 32);
                    const bf16x8 vf = __builtin_bit_cast(bf16x8, (u32x4){vlo.x, vlo.y, vhi.x, vhi.y});
                    o[0][dt] = __builtin_amdgcn_mfma_f32_16x16x32_bf16(vf, pf[0], o[0][dt], 0, 0, 0); o[1][dt] = __builtin_amdgcn_mfma_f32_16x16x32_bf16(vf, pf[1], o[1][dt], 0, 0, 0); } }
#pragma unroll
            for (int hh = 0; hh < 2; ++hh)
#pragma unroll
                for (int dt = 0; dt < 4; ++dt) *(u32x2*)(AO + qtok * D + (kh * 8 + 2 * gp + hh) * 64 + 16 * dt + 4 * q4) = (u32x2){cvt_pk_bf16(o[hh][dt][0] * inv[hh], o[hh][dt][1] * inv[hh]), cvt_pk_bf16(o[hh][dt][2] * inv[hh], o[hh][dt][3] * inv[hh])};
        }
        __syncthreads();
    }
}

struct MoeMeta { int* re; float* rw; int* pos; int* cnt; int* tile; };
template <bool FP8>
DI void moe_route_phase(const Frame& F, const bf16_t* X, const float* gain, const float* wr, bf16_t* XN, const MoeMeta& mm) {
    LAS float* wl = (LAS float*)F.lds;
    LAS int* cl = (LAS int*)(F.lds + 32768);
    for (int q = F.tid; q < 2048; q += NTHR) { const int k = q >> 1, h = q & 1, L = (k & 255) >> 2, i = k & 3, j = k >> 8; ((LAS f32x4*)wl)[((j * 4 + i) * 2 + h) * 64 + L] = *(const f32x4*)(wr + 4 * q); }
    f32x4 gv[4]; load_row(gain, F.lane, gv);
    for (int blk = blockIdx.x; blk < T / 128; blk += F.G) {
        if (F.tid < 8) cl[F.tid] = 0;
        __syncthreads();
        f32x4 vn[4]; load_row(X + (size_t)(blk * 128 + F.wave * 16) * D, F.lane, vn);
        for (int ti = 0; ti < 16; ++ti) { const int t = blk * 128 + F.wave * 16 + ti;
            f32x4 v[4];
#pragma unroll
            for (int j = 0; j < 4; ++j) v[j] = vn[j];
            if (ti < 15) load_row(X + (size_t)(t + 1) * D, F.lane, vn);
            const float rs = row_rstd(v);
            float lg[8];
#pragma unroll
            for (int e = 0; e < 8; ++e) lg[e] = 0.f;
#pragma unroll
            for (int j = 0; j < 4; ++j) { float hv[4];
#pragma unroll
                for (int i = 0; i < 4; ++i) hv[i] = v[j][i] * rs * gv[j][i];
                if constexpr (FP8) { *(unsigned*)((unsigned char*)XN + (size_t)t * D + 4 * F.lane + 256 * j) = cvt4_fp8(hv[0], hv[1], hv[2], hv[3]); }
                else { u32x2 w; w.x = cvt_pk_bf16(hv[0], hv[1]); w.y = cvt_pk_bf16(hv[2], hv[3]); *(u32x2*)(XN + (size_t)t * D + 4 * F.lane + 256 * j) = w; }
#pragma unroll
                for (int i = 0; i < 4; ++i) { const LAS f32x4* wp = (const LAS f32x4*)wl + ((j * 4 + i) * 2) * 64 + F.lane; const f32x4 w0 = wp[0], w1 = wp[64];
                    lg[0] += hv[i] * w0[0]; lg[1] += hv[i] * w0[1]; lg[2] += hv[i] * w0[2]; lg[3] += hv[i] * w0[3]; lg[4] += hv[i] * w1[0]; lg[5] += hv[i] * w1[1]; lg[6] += hv[i] * w1[2]; lg[7] += hv[i] * w1[3]; } }
#pragma unroll
            for (int e = 0; e < 8; ++e) lg[e] = wave_sum(lg[e]);
            int e0 = 0; float v0 = lg[0];
#pragma unroll
            for (int e = 1; e < 8; ++e) if (lg[e] > v0) { v0 = lg[e]; e0 = e; }
            int e1 = -1; float v1 = -3.0e38f;
#pragma unroll
            for (int e = 0; e < 8; ++e) if (e != e0 && lg[e] > v1) { v1 = lg[e]; e1 = e; }
            if (F.lane == 0) { const float ex = expf(v1 - v0), w0 = 1.f / (1.f + ex); mm.re[t] = e0 | (e1 << 8); mm.rw[2 * t] = w0; mm.rw[2 * t + 1] = ex * w0; __hip_atomic_fetch_add(cl + e0, 1, __ATOMIC_RELAXED, __HIP_MEMORY_SCOPE_WORKGROUP); __hip_atomic_fetch_add(cl + e1, 1, __ATOMIC_RELAXED, __HIP_MEMORY_SCOPE_WORKGROUP); }
        }
        __syncthreads();
        if (F.tid < 8) mm.cnt[blk * 8 + F.tid] = cl[F.tid];
        __syncthreads();
    }
}
template <bool FP8>
DI void moe_dispatch_phase(const Frame& F, const bf16_t* XN, bf16_t* XS, const MoeMeta& mm) {
    LAS int* pre = (LAS int*)F.lds;
    LAS int* base = (LAS int*)(F.lds + 8192);
    LAS int* posl = (LAS int*)(F.lds + 8192 + 64);
    constexpr int NB = T / 128;
    for (int i = F.tid; i < NB * 8; i += NTHR) pre[i] = __hip_atomic_load(mm.cnt + i, __ATOMIC_RELAXED, __HIP_MEMORY_SCOPE_AGENT);
    __syncthreads();
    {
      static_assert(NB == 256 && NWAVES == 8, "one wave per expert, four blocks per lane");
      const int e = F.wave; int cb[4], s = 0;
#pragma unroll
      for (int k = 0; k < 4; ++k) { cb[k] = pre[(4 * F.lane + k) * 8 + e]; s += cb[k]; }
      int inc = s;
#pragma unroll
      for (int off = 1; off < 64; off <<= 1) { const int o = __shfl_up(inc, off); if (F.lane >= off) inc += o; }
      int run = inc - s;
#pragma unroll
      for (int k = 0; k < 4; ++k) { pre[(4 * F.lane + k) * 8 + e] = run; run += cb[k]; }
      if (F.lane == 63) base[8 + e] = (inc + 255) & ~255; }
    __syncthreads();
    if (F.tid == 0) { int run = 0; for (int e = 0; e < 8; ++e) { base[e] = run; run += base[8 + e]; }
        if (blockIdx.x == 0) { int nt = 0; for (int e = 0; e < 8; ++e) { const int ntile = base[8 + e] >> 8; for (int k = 0; k < ntile; ++k) mm.tile[nt + k] = e; nt += ntile; } mm.tile[MOE_TILES] = nt; } }
    __syncthreads();
    for (int blk = blockIdx.x; blk < NB; blk += F.G) {
        if (F.wave == 0) { int run[8];
#pragma unroll
            for (int e = 0; e < 8; ++e) run[e] = base[e] + pre[blk * 8 + e];
            for (int hf = 0; hf < 2; ++hf) { const int tl = hf * 64 + F.lane, t = blk * 128 + tl; const int re = __hip_atomic_load(mm.re + t, __ATOMIC_RELAXED, __HIP_MEMORY_SCOPE_AGENT), e0 = re & 255, e1 = re >> 8; int p0 = 0, p1 = 0;
#pragma unroll
                for (int e = 0; e < 8; ++e) { const unsigned long long m = __ballot((e0 == e) || (e1 == e)); const int rank = __popcll(m & ((1ull << F.lane) - 1ull));
                    if (e0 == e) p0 = run[e] + rank; if (e1 == e) p1 = run[e] + rank; run[e] += __popcll(m); }
                posl[2 * tl] = p0; posl[2 * tl + 1] = p1; mm.pos[2 * t] = p0; mm.pos[2 * t + 1] = p1; } }
        __syncthreads();
        for (int rc = F.wave; rc < 256; rc += NWAVES) { const int tl = rc >> 1, t = blk * 128 + tl, ps = posl[rc];
            if constexpr (FP8) { *((u32x4*)((unsigned char*)XS + (size_t)ps * D) + F.lane) = *((const u32x4*)((const unsigned char*)XN + (size_t)t * D) + F.lane); }
            else { const u32x4* src = (const u32x4*)(XN + (size_t)t * D) + 2 * F.lane; u32x4* dst = (u32x4*)(XS + (size_t)ps * D) + 2 * F.lane; const u32x4 a = src[0], c = src[1]; dst[0] = a; dst[1] = c; } }
        __syncthreads();
    }
}
template <bool FINAL>
DI void moe_combine_phase(const Frame& F, bf16_t* X, const bf16_t* YS, const bf16_t* PART, const MoeMeta& mm, const float* gain, bf16_t* XN, float* OUT) {
    f32x4 gv[4]; load_row(gain, F.lane, gv);
    int nsr; { int R, nsp; pg8::sk_split(__hip_atomic_load(mm.tile + MOE_TILES, __ATOMIC_RELAXED, __HIP_MEMORY_SCOPE_AGENT), D / 256, F.G, R, nsp); nsr = nsp * 256; }
    for (int t = F.gw; t < T; t += F.ngw) {
        const int p0 = __hip_atomic_load(mm.pos + 2 * t, __ATOMIC_RELAXED, __HIP_MEMORY_SCOPE_AGENT), p1 = __hip_atomic_load(mm.pos + 2 * t + 1, __ATOMIC_RELAXED, __HIP_MEMORY_SCOPE_AGENT);
        const float w0 = __hip_atomic_load(mm.rw + 2 * t, __ATOMIC_RELAXED, __HIP_MEMORY_SCOPE_AGENT), w1 = __hip_atomic_load(mm.rw + 2 * t + 1, __ATOMIC_RELAXED, __HIP_MEMORY_SCOPE_AGENT);
        f32x4 v[4]; load_row(X + (size_t)t * D, F.lane, v);
#pragma unroll
        for (int j = 0; j < 4; ++j) { const u32x2 a = *(const u32x2*)(YS + (size_t)p0 * D + 4 * F.lane + 256 * j), c = *(const u32x2*)(YS + (size_t)p1 * D + 4 * F.lane + 256 * j);
            v[j][0] += w0 * bf_lo(a.x) + w1 * bf_lo(c.x); v[j][1] += w0 * bf_hi(a.x) + w1 * bf_hi(c.x); v[j][2] += w0 * bf_lo(a.y) + w1 * bf_lo(c.y); v[j][3] += w0 * bf_hi(a.y) + w1 * bf_hi(c.y); }
        if (p0 < nsr || p1 < nsr) {
#pragma unroll 1
            for (int s = 0; s < 2; ++s) { const int p = s ? p1 : p0; const float w = s ? w1 : w0; if (p >= nsr) continue;
#pragma unroll 1
                for (int ch = 0; ch < pg8::SK_NCH - 1; ++ch) { const bf16_t* pp = PART + (size_t)ch * SK_PART_STRIDE + (size_t)p * D + 4 * F.lane;
#pragma unroll
                    for (int j = 0; j < 4; ++j) { const u32x2 a = *(const u32x2*)(pp + 256 * j); v[j][0] += w * bf_lo(a.x); v[j][1] += w * bf_hi(a.x); v[j][2] += w * bf_lo(a.y); v[j][3] += w * bf_hi(a.y); } } }
        }
        const float rs = row_rstd(v);
#pragma unroll
        for (int j = 0; j < 4; ++j) {
            if (FINAL) { *(f32x4*)(OUT + (size_t)t * D + 4 * F.lane + 256 * j) = (f32x4){v[j][0] * rs * gv[j][0], v[j][1] * rs * gv[j][1], v[j][2] * rs * gv[j][2], v[j][3] * rs * gv[j][3]}; }
            else { *(u32x2*)(X + (size_t)t * D + 4 * F.lane + 256 * j) = (u32x2){cvt_pk_bf16(v[j][0], v[j][1]), cvt_pk_bf16(v[j][2], v[j][3])};
                u32x2 w; w.x = cvt_pk_bf16(v[j][0] * rs * gv[j][0], v[j][1] * rs * gv[j][1]); w.y = cvt_pk_bf16(v[j][2] * rs * gv[j][2], v[j][3] * rs * gv[j][3]); *(u32x2*)(XN + (size_t)t * D + 4 * F.lane + 256 * j) = w; } }
    }
}

constexpr int NPHASE = 33;
struct Args { const float* in[50]; float* out; unsigned char* ws; int ph_lo, ph_hi; };
__global__ void __launch_bounds__(NTHR, 2) trunk_fwd(Args args) {
    extern __shared__ __attribute__((aligned(16))) unsigned char lds_raw[];
    Frame F;
    F.lds = (LAS unsigned char*)lds_raw;
    F.tid = threadIdx.x; F.lane = F.tid & 63; F.wave = __builtin_amdgcn_readfirstlane(F.tid >> 6);
    F.G = gridDim.x; F.gw = blockIdx.x * NWAVES + F.wave; F.ngw = F.G * NWAVES;
    const Frame F0 = F;
    unsigned char* ws = args.ws;
    volatile LAS unsigned* MISC = (volatile LAS unsigned*)(F.lds + LDS_MISC_OFF);
    if (F.tid < 64) MISC[F.tid] = 0u;
    __syncthreads();
#if !MK_PER_PHASE
    XcdBarrier bar = xcd_barrier_post((unsigned*)(ws + WS_CTL) + CW_BAR, MISC + 8);
#define GRID_BAR() xcd_barrier(bar)
#else
#define GRID_BAR() do {} while (0)
#endif
    const int lo = args.ph_lo, hi = args.ph_hi;
#define IN(k) (lo <= (k) && (k) < hi)
#define SEAM(k) do { if (IN(k) && IN((k) + 1)) GRID_BAR(); } while (0)
    LAS unsigned char* lds = F.lds;
    const int G = F.G, c = (int)blockIdx.x;
    bf16_t* XN = (bf16_t*)(ws + WS_XN);
    unsigned char* WA = ws + WS_WA; unsigned char* ACT = ws + WS_ACT;
    bf16_t* XRES = (bf16_t*)(ACT + AC_XB);

#define S5_PARAMS(base) S5P{args.in[(base)], args.in[(base) + 1], args.in[(base) + 2], args.in[(base) + 3], args.in[(base) + 4], args.in[(base) + 5], args.in[(base) + 6], args.in[(base) + 7], args.in[(base) + 8], args.in[(base) + 9]}
#define S5_PREP(pbase, xin, ln) { const S5P sp = S5_PARAMS(pbase); \
        convert_matrix(F, sp.w_glu, D, D, D, (bf16_t*)(WA + WA_WGLU), D, RowId{}, 1, 0, 0); \
        __syncthreads(); s5_tables_phase(F, sp, (bf16_t*)(WA + WA_TG), (bf16_t*)(WA + WA_FG)); \
        norm_to_ug_phase(F, xin, ln, (bf16_t*)(ACT + AC_UG), XRES); }
#define S5_SLOC(pbase) { pg8::Gemm g{(const bf16_t*)(ACT + AC_UG), (const bf16_t*)(WA + WA_FG), S5LD, S5K, S5K}; \
        pg8::BatchOrder S{64, S5ROWS / 256, 1, G, c, 256L * S5LD * 2, 256L * S5K * 2, (long)S5ROWS * S5LD * 2, 256L * S5K * 2}; \
        pg8::EpiSloc E{(float*)(ACT + AC_SLOC)}; pg8::gemm_phase(lds, F.tid, g, S, E); \
        __syncthreads();     \
        { const S5P sp = S5_PARAMS(pbase); pg8::Unit u; for (int i = 0; S.next(i, u); ++i) s5_scan_tile(F, sp, (const float*)(ACT + AC_SLOC), (bf16_t*)(ACT + AC_UG), u.aux, u.pm); } }
#define S5_SCAN(pbase) { const S5P sp = S5_PARAMS(pbase); s5_scan_phase(F, sp, (const float*)(ACT + AC_SLOC), (bf16_t*)(ACT + AC_UG)); }
#define S5_Y(pbase) { pg8::Gemm g{(const bf16_t*)(ACT + AC_UG), (const bf16_t*)(WA + WA_TG), S5LD, S5LD, S5LD}; \
        pg8::BatchOrder S{64, S5ROWS / 256, S5K / 256, G, c, 256L * S5LD * 2, 256L * S5LD * 2, (long)S5ROWS * S5LD * 2, (long)S5K * S5LD * 2}; \
        pg8::EpiS5Y E{(bf16_t*)(ACT + AC_YMAT)}; pg8::gemm_phase(lds, F.tid, g, S, E); }
#define S5_GLU(pbase, xin, XBF) { pg8::Gemm g{(const bf16_t*)(ACT + AC_YMAT), (const bf16_t*)(WA + WA_WGLU), 16, D, D, T * 32}; \
        pg8::PlainOrder S; S.init(T, D, G, c, 16, D); pg8::EpiGlu<XBF> E{xin, XRES, (const bf16_t*)(ACT + AC_YMAT), args.in[(pbase) + 9]}; pg8::gemm_phase(lds, F.tid, g, S, E); }
#define FFN_CONVERT(wbase) do { convert_matrix(F, args.in[(wbase)], D, 2 * FFN_H, 2 * FFN_H, (bf16_t*)(WA + WA_FGU), D, RowGU{FFN_H}, 1, 0, 0); \
        convert_matrix(F, args.in[(wbase) + 1], FFN_H, D, D, (bf16_t*)(WA + WA_FDN), FFN_H, RowId{}, 1, 0, 0); } while (0)
#define FFN_CONVERT8(wbase) do { convert_matrix8(F, args.in[(wbase)], D, 2 * FFN_H, 2 * FFN_H, (unsigned char*)(WA + WA_FGU), D, RowGU{FFN_H}, 1, 0, 0); \
        convert_matrix8(F, args.in[(wbase) + 1], FFN_H, D, D, (unsigned char*)(WA + WA_FDN), FFN_H, RowId{}, 1, 0, 0); } while (0)
#define FFN_GU8() { pg8::Gemm g{XN, (const bf16_t*)(WA + WA_FGU), D / 2, D / 2, D / 2}; pg8::PlainOrder S; S.init(T, 2 * FFN_H, G, c, D / 2, D / 2); \
        pg8::EpiSwiGLU8 E{(unsigned char*)(ACT + AC_H), (size_t)T * 32}; pg8::gemm_phase<pg8::EpiSwiGLU8, pg8::PlainOrder, true>(lds, F.tid, g, S, E); }
#define FFN_DN8() { pg8::Gemm g{(const bf16_t*)(ACT + AC_H), (const bf16_t*)(WA + WA_FDN), 16, FFN_H / 2, FFN_H / 2, T * 32}; pg8::PlainOrder S; S.init(T, D, G, c, 16, FFN_H / 2);     \
        pg8::EpiResAdd E{XRES, nullptr}; pg8::gemm_phase<pg8::EpiResAdd, pg8::PlainOrder, true>(lds, F.tid, g, S, E); }
#define FFN_GU() { pg8::Gemm g{XN, (const bf16_t*)(WA + WA_FGU), D, D, D}; pg8::PlainOrderB S; S.init(T, 2 * FFN_H, G, c, D, D); \
        pg8::EpiSwiGLU E{(bf16_t*)(ACT + AC_H), FFN_H}; pg8::gemm_phase(lds, F.tid, g, S, E); }
#define FFN_DN() { pg8::Gemm g{(const bf16_t*)(ACT + AC_H), (const bf16_t*)(WA + WA_FDN), FFN_H, FFN_H, FFN_H}; pg8::PlainOrder S; S.init(T, D, G, c, FFN_H, FFN_H); \
        pg8::EpiResAdd E{XRES, nullptr}; pg8::gemm_phase(lds, F.tid, g, S, E); }
#define MOE_META(set) MoeMeta{(int*)(ws + WS_MISC + (set) * MS_SET + MS_RE), (float*)(ws + WS_MISC + (set) * MS_SET + MS_RW), (int*)(ws + WS_MISC + (set) * MS_SET + MS_POS), \
        (int*)(ws + WS_MISC + (set) * MS_SET + MS_CNT), (int*)(ws + WS_MISC + (set) * MS_SET + MS_TILE)}
#define MOE_ROUTE(set, ln, wbase) { const MoeMeta mm = MOE_META(set); \
        convert_matrix(F, args.in[(wbase) + 1], D, 2 * EXP_H, 2 * EXP_H, (bf16_t*)(WA + WA_MGU), D, RowGU{EXP_H}, NEXP, (size_t)D * 2 * EXP_H, (size_t)D * 2 * EXP_H); \
        convert_matrix(F, args.in[(wbase) + 2], EXP_H, D, D, (bf16_t*)(WA + WA_MDN), EXP_H, RowId{}, NEXP, (size_t)D * EXP_H, (size_t)D * EXP_H); \
        __syncthreads(); moe_route_phase<false>(F, XRES, ln, args.in[(wbase)], XN, mm); }
#define MOE_ROUTE8(set, ln, wbase) { const MoeMeta mm = MOE_META(set); \
        convert_matrix8(F, args.in[(wbase) + 1], D, 2 * EXP_H, 2 * EXP_H, (unsigned char*)(WA + WA_MGU), D, RowGU{EXP_H}, NEXP, (size_t)D * 2 * EXP_H, (size_t)D * 2 * EXP_H); \
        convert_matrix8(F, args.in[(wbase) + 2], EXP_H, D, D, (unsigned char*)(WA + WA_MDN), EXP_H, RowId{}, NEXP, (size_t)D * EXP_H, (size_t)D * EXP_H); \
        __syncthreads(); moe_route_phase<true>(F, XRES, ln, args.in[(wbase)], XN, mm); }
#define MOE_DISPATCH(set) { const MoeMeta mm = MOE_META(set); moe_dispatch_phase<false>(F, XN, (bf16_t*)(ACT + AC_XS), mm); }
#define MOE_DISPATCH8(set) { const MoeMeta mm = MOE_META(set); moe_dispatch_phase<true>(F, XN, (bf16_t*)(ACT + AC_XS), mm); }
#define MOE_LOAD_TILES(set) const MoeMeta mm = MOE_META(set); LAS int* tl = (LAS int*)(lds + LDS_MISC_OFF + 256); \
        for (int i = F.tid; i <= MOE_TILES; i += NTHR) tl[i] = __hip_atomic_load(mm.tile + i, __ATOMIC_RELAXED, __HIP_MEMORY_SCOPE_AGENT); __syncthreads(); \
        const int ntile = tl[MOE_TILES];
#define MOE_GU(set) { MOE_LOAD_TILES(set) pg8::Gemm g{(const bf16_t*)(ACT + AC_XS), (const bf16_t*)(WA + WA_MGU), D, D, D}; \
        pg8::MoeOrder S{ntile, 2 * EXP_H / 256, G, c, 256L * D * 2, 256L * D * 2, (long)2 * EXP_H * D * 2, tl, 0}; \
        pg8::EpiSwiGLU E{(bf16_t*)(ACT + AC_HID), EXP_H}; pg8::gemm_phase(lds, F.tid, g, S, E); }
#define MOE_DN(set) { MOE_LOAD_TILES(set) pg8::Gemm g{(const bf16_t*)(ACT + AC_HID), (const bf16_t*)(WA + WA_MDN), EXP_H, EXP_H, EXP_H}; \
        pg8::MoeOrder S{ntile, D / 256, G, c, 256L * EXP_H * 2, 256L * EXP_H * 2, (long)D * EXP_H * 2, tl, 1}; \
        pg8::EpiStoreBf16 E{(bf16_t*)(ACT + AC_XS), D, nullptr}; pg8::gemm_phase(lds, F.tid, g, S, E); }
#define MOE_GU8(set) { MOE_LOAD_TILES(set) pg8::Gemm g{(const bf16_t*)(ACT + AC_XS), (const bf16_t*)(WA + WA_MGU), D / 2, D / 2, D / 2}; \
        pg8::MoeOrder S{ntile, 2 * EXP_H / 256, G, c, 256L * D, 256L * D, (long)2 * EXP_H * D, tl, 0}; \
        pg8::EpiSwiGLU8 E{(unsigned char*)(ACT + AC_HID), HID_GS}; pg8::gemm_phase<pg8::EpiSwiGLU8, pg8::MoeOrder, true>(lds, F.tid, g, S, E); }
#define MOE_DN8(set) { MOE_LOAD_TILES(set) pg8::Gemm g{(const bf16_t*)(ACT + AC_HID), (const bf16_t*)(WA + WA_MDN), 16, EXP_H / 2, EXP_H / 2, (int)HID_GS};     \
        pg8::MoeOrderSK S{ntile, D / 256, G, c, 256L * 32, 256L * EXP_H, (long)D * EXP_H, tl, (long)((AC_PART - AC_XS) / 2), (long)SK_PART_STRIDE, 4L * (long)HID_GS, 0, 0}; S.init(); \
        pg8::EpiStoreBf16 E{(bf16_t*)(ACT + AC_XS), D, nullptr}; pg8::gemm_phase<pg8::EpiStoreBf16, pg8::MoeOrderSK, true>(lds, F.tid, g, S, E); }

#define PH_REPS(k) (1 + PROBE_N * (int)(((unsigned long long)(PROBE_MASK) >> (k)) & 1ull))
#define PH(k, ...) do { for (int _r = 0; _r < PH_REPS(k); ++_r) { if (IN(k)) { Frame F = F0; { int _t = threadIdx.x; asm volatile("" : "+v"(_t)); F.tid = _t; F.lane = _t & 63; F.wave = __builtin_amdgcn_readfirstlane(_t >> 6); F.gw = blockIdx.x * NWAVES + F.wave; } \
        __VA_ARGS__ } if (_r + 1 < PH_REPS(k)) GRID_BAR(); } SEAM(k); } while (0)
    PH(0, S5_PREP(2, args.in[0], args.in[1]) if (FFN0_FP8) { FFN_CONVERT8(13); } else { FFN_CONVERT(13); });
    PH(1, S5_SLOC(2));
    PH(2, S5_Y(2));
    PH(3, S5_GLU(2, XRES, true));
    PH(4, norm_phase<FFN0_FP8 != 0>(F, XRES, args.in[12], XN););
    PH(5, if (FFN0_FP8) FFN_GU8() else FFN_GU());
    PH(6, if (FFN0_FP8) FFN_DN8() else FFN_DN());
    PH(7, convert_matrix(F, args.in[16], D, 3072, 3088, (bf16_t*)(WA + WA_WIN), D, RowId{}, 1, 0, 0);
          for (int id = blockIdx.x * NTHR + F.tid; id < 16 * D; id += G * NTHR) { const int j = id >> 10, k = id & 1023; ((bf16_t*)(WA + WA_WIN))[(size_t)(3072 + j) * D + k] = f2bf(args.in[16][(size_t)k * 3088 + 3072 + j]); }
          convert_matrix(F, args.in[20], D, D, D, (bf16_t*)(WA + WA_WOUT), D, RowId{}, 1, 0, 0);
          norm_phase(F, XRES, args.in[15], XN););
    PH(8, { pg8::Gemm g{XN, (const bf16_t*)(WA + WA_WIN), D, D, D}; pg8::PlainOrderB S; S.init(T, GLA_N, G, c, D, D); pg8::EpiStoreBf16 E{(bf16_t*)(ACT + AC_PROJ), GLA_N, nullptr}; pg8::gemm_phase(lds, F.tid, g, S, E); });
    PH(9, gla_prep_phase(F, (const bf16_t*)(ACT + AC_PROJ), args.in[17], args.in[18], (bf16_t*)(ACT + AC_QSB), (bf16_t*)(ACT + AC_KE), (bf16_t*)(ACT + AC_SCB), (float*)(ACT + AC_DEC)););
    PH(10, gla_seq_phase(F, (const bf16_t*)(ACT + AC_QSB), (const bf16_t*)(ACT + AC_KE), (const bf16_t*)(ACT + AC_SCB), (const bf16_t*)(ACT + AC_PROJ), (const float*)(ACT + AC_DEC), (bf16_t*)(ACT + AC_GO)););
    PH(11, gla_finalize_phase(F, (const bf16_t*)(ACT + AC_GO), (const bf16_t*)(ACT + AC_PROJ), args.in[19], XN););
    PH(12, { pg8::Gemm g{XN, (const bf16_t*)(WA + WA_WOUT), D, D, D}; pg8::PlainOrder S; S.init(T, D, G, c, D, D); pg8::EpiResAdd E{XRES, nullptr}; pg8::gemm_phase(lds, F.tid, g, S, E); });
    PH(13, MOE_ROUTE8(0, args.in[21], 22));
    PH(14, MOE_DISPATCH8(0));
    PH(15, MOE_GU8(0));
    PH(16, MOE_DN8(0));
    PH(17, { const MoeMeta mm = MOE_META(0);
          convert_matrix(F, args.in[26], D, QKV_N, QKV_N, (bf16_t*)(WA + WA_QKV), D, RowId{}, 1, 0, 0);
          convert_matrix(F, args.in[29], D, D, D, (bf16_t*)(WA + WA_SWO), D, RowId{}, 1, 0, 0);
          if (FFN2_FP8) { FFN_CONVERT8(32); } else { FFN_CONVERT(32); }
          moe_combine_phase<false>(F, XRES, (const bf16_t*)(ACT + AC_XS), (const bf16_t*)(ACT + AC_PART), mm, args.in[25], XN, nullptr); });
    PH(18, { pg8::Gemm g{XN, (const bf16_t*)(WA + WA_QKV), D, D, D}; pg8::PlainOrder S; S.init(T, QKV_N, G, c, D, D); pg8::EpiStoreBf16 E{(bf16_t*)(ACT + AC_QKV), QKV_N, args.in[27]}; pg8::gemm_phase(lds, F.tid, g, S, E); });
    PH(19, swa_phase(F, (const bf16_t*)(ACT + AC_QKV), args.in[28], (bf16_t*)(ACT + AC_AO)););
    PH(20, { pg8::Gemm g{(const bf16_t*)(ACT + AC_AO), (const bf16_t*)(WA + WA_SWO), D, D, D}; pg8::PlainOrder S; S.init(T, D, G, c, D, D); pg8::EpiResAdd E{XRES, args.in[30]}; pg8::gemm_phase(lds, F.tid, g, S, E); });
    PH(21, norm_phase<FFN2_FP8 != 0>(F, XRES, args.in[31], XN););
    PH(22, if (FFN2_FP8) FFN_GU8() else FFN_GU());
    PH(23, if (FFN2_FP8) FFN_DN8() else FFN_DN());
    PH(24, S5_PREP(35, XRES, args.in[34]));
    PH(25, S5_SLOC(35));
    PH(26, S5_Y(35));
    PH(27, S5_GLU(35, XRES, true));
    PH(28, MOE_ROUTE8(1, args.in[45], 46));
    PH(29, MOE_DISPATCH8(1));
    PH(30, MOE_GU8(1));
    PH(31, MOE_DN8(1));
    PH(32, { const MoeMeta mm = MOE_META(1); moe_combine_phase<true>(F, XRES, (const bf16_t*)(ACT + AC_XS), (const bf16_t*)(ACT + AC_PART), mm, args.in[49], nullptr, args.out); });
}

extern "C" void kernel_launch(void* const* d_in, const int* in_sizes, int n_in, void* d_out, int out_size, void* d_ws, size_t ws_size, hipStream_t stream) {
    static int grid = 0;
    if (grid == 0) {
        if (n_in != 50 || in_sizes[0] != T * D || out_size != T * D || ws_size < WS_END) { fprintf(stderr, "kernel_launch: unexpected problem (n_in %d, in0 %d, out %d, ws %zu < %zu)\n", n_in, n_in > 0 ? in_sizes[0] : -1, out_size, ws_size, (size_t)WS_END); grid = -1; return; }
        int dev = 0, cus = 0, per_cu = 0;
        if (hipGetDevice(&dev) != hipSuccess || hipDeviceGetAttribute(&cus, hipDeviceAttributeMultiprocessorCount, dev) != hipSuccess) { grid = -1; return; }
        if (hipFuncSetAttribute((const void*)trunk_fwd, hipFuncAttributeMaxDynamicSharedMemorySize, LDS_BYTES) != hipSuccess) { fprintf(stderr, "kernel_launch: hipFuncSetAttribute failed\n"); grid = -1; return; }
        if (hipOccupancyMaxActiveBlocksPerMultiprocessor(&per_cu, (const void*)trunk_fwd, NTHR, LDS_BYTES) != hipSuccess || per_cu < 1) fprintf(stderr, "kernel_launch: occupancy query reports %d\n", per_cu);
        (void)hipGetLastError();
        grid = cus;
    }
    if (grid < 0) return;
    (void)hipMemsetAsync((char*)d_ws + WS_CTL, 0, CTL_ZERO_BYTES, stream);
    Args a{};
    for (int i = 0; i < 50; ++i) a.in[i] = (const float*)d_in[i];
    a.out = (float*)d_out; a.ws = (unsigned char*)d_ws;
#if MK_PER_PHASE
    for (int p = 0; p < NPHASE; ++p) { a.ph_lo = p; a.ph_hi = p + 1; hipLaunchKernelGGL(trunk_fwd, dim3(grid), dim3(NTHR), LDS_BYTES, stream, a); }
#else
    a.ph_lo = 0; a.ph_hi = NPHASE; hipLaunchKernelGGL(trunk_fwd, dim3(grid), dim3(NTHR), LDS_BYTES, stream, a);
#endif
}
```

```cpp
#include <hip/hip_runtime.h>
#include <cstdio>
#include <cstdint>

#ifndef PROBE_MASK
#define PROBE_MASK 0ull
#define PROBE_N 2
#endif
#ifndef FFN2_FP8
#define FFN2_FP8 1
#endif
#ifndef FFN0_FP8
#define FFN0_FP8 0
#endif
#ifndef MK_PER_PHASE
#define MK_PER_PHASE 0
#endif

#define DI __device__ __forceinline__
#define LAS __attribute__((address_space(3)))
typedef unsigned short bf16_t;
typedef short bf16x8 __attribute__((ext_vector_type(8)));
typedef short s16x4 __attribute__((ext_vector_type(4)));
typedef float f32x4 __attribute__((ext_vector_type(4)));
typedef float f32x2 __attribute__((ext_vector_type(2)));
typedef unsigned u32x4 __attribute__((ext_vector_type(4)));
typedef unsigned u32x2 __attribute__((ext_vector_type(2)));

constexpr int T = 32768, D = 1024, SEQ = 2048, BATCH = 16;
constexpr int NWAVES = 8, NTHR = 512;
constexpr float EPS = 1e-6f;
constexpr int FFN_H = 2816, EXP_H = 3584, NEXP = 8;
constexpr int S5C = 32;
constexpr int S5ROWS = BATCH * (SEQ / S5C);
constexpr int S5K = S5C * 16;
constexpr int S5LD = S5K + 128;
constexpr int GLA_N = 3328;
constexpr int QKV_N = 1280;
constexpr int MOE_ROWS = 67584;
constexpr int MOE_TILES = 264;

constexpr size_t MiB = 1u << 20;
constexpr size_t WS_CTL = 0, CTL_ZERO_BYTES = 64 * 1024;
constexpr size_t WS_MISC = 1 * MiB;
constexpr size_t WS_WA = 4 * MiB;
constexpr size_t WS_XN = 174 * MiB;
constexpr size_t WS_ACT = 238 * MiB;
constexpr size_t WS_END = WS_ACT + 596 * MiB;
constexpr size_t WA_WGLU = 0, WA_TG = 2 * MiB, WA_FG = 42 * MiB, WA_FGU = 58 * MiB, WA_FDN = 69 * MiB;
constexpr size_t WA_WIN = 0, WA_WOUT = 7 * MiB;
constexpr size_t WA_MGU = 0, WA_MDN = 112 * MiB;
constexpr size_t WA_QKV = 0, WA_SWO = 3 * MiB;
constexpr size_t AC_UG = 0, AC_SLOC = 80 * MiB, AC_YMAT = 112 * MiB;
constexpr size_t AC_H = 0;
constexpr size_t AC_PROJ = 0, AC_GO = 208 * MiB, AC_KE = 272 * MiB, AC_SCB = 304 * MiB, AC_VTG = 320 * MiB, AC_DEC = 384 * MiB, AC_QSB = 386 * MiB;
constexpr size_t AC_XS = 0, AC_HID = 132 * MiB, AC_PART = 496 * MiB;
constexpr size_t HID_GS = (size_t)MOE_TILES * 256 * 32;
constexpr size_t SK_PART_STRIDE = (size_t)2048 * D;
constexpr size_t AC_QKV = 0, AC_AO = 80 * MiB;
constexpr size_t AC_XB = 424 * MiB;
constexpr size_t MS_SET = 1 * MiB;
constexpr size_t MS_RE = 0, MS_RW = 128 * 1024, MS_POS = 384 * 1024, MS_CNT = 640 * 1024, MS_TILE = 656 * 1024;
constexpr int CW_BAR = 1024;

constexpr int STAGE_BYTES = 131072;
constexpr int LDS_BYTES = 147456;
constexpr int LDS_MISC_OFF = LDS_BYTES - 2048;

typedef __bf16 bf16x2_t __attribute__((ext_vector_type(2)));
DI unsigned cvt_pk_bf16(float lo, float hi) { const bf16x2_t v = __builtin_convertvector((f32x2){lo, hi}, bf16x2_t); return __builtin_bit_cast(unsigned, v); }
typedef int i32x8 __attribute__((ext_vector_type(8)));
typedef int i32x4 __attribute__((ext_vector_type(4)));
DI unsigned cvt4_fp8(float a, float b, float c, float d) { int r = 0; r = __builtin_amdgcn_cvt_pk_fp8_f32(a, b, r, false); r = __builtin_amdgcn_cvt_pk_fp8_f32(c, d, r, true); return (unsigned)r; }
constexpr float W8_SCALE = 64.f;
DI float bf_lo(unsigned w) { return __uint_as_float(w << 16); }
DI float bf_hi(unsigned w) { return __uint_as_float(w & 0xffff0000u); }
DI float bf2f(bf16_t v) { return __uint_as_float(((unsigned)v) << 16); }
DI bf16_t f2bf(float f) { return (bf16_t)(cvt_pk_bf16(f, 0.f) & 0xffffu); }
DI float wave_sum(float v) {
#pragma unroll
    for (int o = 1; o < 64; o <<= 1) v += __shfl_xor(v, o);
    return v;
}
DI float sigmoid_f(float z) { return __builtin_amdgcn_rcpf(1.f + __builtin_amdgcn_exp2f(z * -1.4426950408889634f)); }
DI float silu_f(float z) { return z * sigmoid_f(z); }
DI f32x2 swiglu2(f32x2 g, f32x2 u) { const f32x2 t = g * -1.4426950408889634f; f32x2 e; e.x = __builtin_amdgcn_exp2f(t.x); e.y = __builtin_amdgcn_exp2f(t.y);
    const f32x2 d = e + 1.0f; f32x2 r; r.x = __builtin_amdgcn_rcpf(d.x); r.y = __builtin_amdgcn_rcpf(d.y); return (g * r) * u; }
DI f32x2 sigmoid2(f32x2 z) { const f32x2 t = z * -1.4426950408889634f; f32x2 e; e.x = __builtin_amdgcn_exp2f(t.x); e.y = __builtin_amdgcn_exp2f(t.y); const f32x2 d = e + 1.0f; f32x2 r; r.x = __builtin_amdgcn_rcpf(d.x); r.y = __builtin_amdgcn_rcpf(d.y); return r; }
DI f32x2 gelu_tanh2(f32x2 x) { const f32x2 u = (x * x * 0.044715f + 1.0f) * x * 1.5957691216f; return x * sigmoid2(u); }
DI float gelu_tanh_f(float x) { const float u = 1.5957691216f * (x + 0.044715f * x * x * x); return x * sigmoid_f(u); }
#define LDS_WAIT() asm volatile("s_waitcnt lgkmcnt(0)" ::: "memory")
#define LDS_BARRIER() do { asm volatile("s_waitcnt lgkmcnt(0)" ::: "memory"); __builtin_amdgcn_s_barrier(); asm volatile("" ::: "memory"); } while (0)

namespace pg8 {
constexpr int BM = 256, BK = 64, HALF = 128, HTB = HALF * BK * 2, NXCD = 8, WGM = 8;
__host__ __device__ __forceinline__ int lds_byte(int r, int c) { const int st = (r >> 4) * 2 + (c >> 5), rr = r & 15, cc = c & 31, ob = rr * 64 + cc * 2; return st * 1024 + (ob ^ (((ob >> 9) & 1) << 5)); }
__host__ __device__ __forceinline__ void stage_rc(int b, int& R, int& C) { const int st = b / 1024, sb = b % 1024, swz = sb ^ (((sb >> 9) & 1) << 5); R = (st >> 1) * 16 + swz / 64; C = (st & 1) * 32 + (swz % 64) / 2; }
__host__ __device__ __forceinline__ int perm32(int rho) { const int n = rho >> 4, i = rho & 15; return 8 * (i >> 2) + 4 * n + (i & 3); }

struct Unit { int pm, pn, aux; long aoff, boff; int kt = 0; long ooff = 0; };
struct Gemm { const bf16_t* A; const bf16_t* Bt; int lda, ldb, K; int a_cs16 = 32; };

DI bool tile_of(long L, int nM, int nN, int& pm, int& pn) {
    const int nwg = nM * nN; if (L >= nwg) return false;
    int wgid = (int)L; { const int q = nwg / NXCD, r = nwg % NXCD, xcd = wgid % NXCD, off = wgid / NXCD; wgid = (xcd < r ? xcd * (q + 1) : r * (q + 1) + (xcd - r) * q) + off; }
    const int nig = WGM * nN, gid = wgid / nig, fm = gid * WGM, gsz = (nM - fm) < WGM ? (nM - fm) : WGM;
    pm = fm + ((wgid % nig) % gsz); pn = (wgid % nig) / gsz; return true;
}
DI bool tile_of_bhot(long L, int nM, int nN, int& pm, int& pn) {
    const int nwg = nM * nN; if (L >= nwg) return false;
    int wgid = (int)L; { const int q = nwg / NXCD, r = nwg % NXCD, xcd = wgid % NXCD, off = wgid / NXCD; wgid = (xcd < r ? xcd * (q + 1) : r * (q + 1) + (xcd - r) * q) + off; }
    const int full = nN >> 2, idsFull = full * 4 * nM; int cg, r, cw;
    if (wgid < idsFull) { cg = wgid / (4 * nM); r = wgid % (4 * nM); cw = 4; } else { cg = full; r = wgid - idsFull; cw = nN & 3; }
    const int rb = r / (8 * cw), q = r % (8 * cw);
    pm = rb * 8 + (q & 7); pn = 4 * cg + (q >> 3); return true;
}
struct PlainOrder {
    int nM, nN, G, c; long atile, btile;
    DI void init(int M, int N, int G_, int c_, int lda, int ldb) { nM = M / BM; nN = N / BM; G = G_; c = c_; atile = (long)BM * lda * 2; btile = (long)BM * ldb * 2; }
    DI bool next(int i, Unit& u) const { int pm, pn; if (!tile_of((long)i * G + c, nM, nN, pm, pn)) return false; u.pm = pm; u.pn = pn; u.aux = 0; u.aoff = pm * atile; u.boff = pn * btile; return true; }
};
struct PlainOrderB : PlainOrder {
    DI bool next(int i, Unit& u) const { int pm, pn; if (!tile_of_bhot((long)i * G + c, nM, nN, pm, pn)) return false; u.pm = pm; u.pn = pn; u.aux = 0; u.aoff = pm * atile; u.boff = pn * btile; return true; }
};
struct BatchOrder {
    int ng, nM, nN, G, c; long atile, btile, astride, bstride;
    DI bool next(int i, Unit& u) const {
        const long L0 = (long)i * G + c; const int per = nM * nN, nwg = ng * per; if (L0 >= (long)nwg) return false;
        int L = (int)L0; { const int q = nwg / NXCD, r = nwg % NXCD, xcd = L % NXCD, off = L / NXCD; L = (xcd < r ? xcd * (q + 1) : r * (q + 1) + (xcd - r) * q) + off; }
        const int g = (int)(L / per), r = (int)(L % per); u.pm = r % nM; u.pn = r / nM; u.aux = g;
        u.aoff = g * astride + u.pm * atile; u.boff = g * bstride + u.pn * btile; return true; }
};
struct HalfOrder {
    int nM, pn, G, c; long atile, btile;
    DI bool next(int i, Unit& u) const { const int L = i * G + c; if (L >= 2 * nM) return false; const int xcd = L & 7, off = L >> 3, pm = xcd * (nM >> 3) + (off >> 1), h = off & 1;
        u.pm = pm; u.pn = pn; u.aux = 0; u.kt = 0; u.ooff = 128 * h; u.aoff = pm * atile; u.boff = pn * btile + h * (btile >> 1); return true; }
};
struct MoeOrder {
    int nM, nN, G, c; long atile, btile, bstride; const LAS int* tile_e; int rev;
    DI bool next(int i, Unit& u) const { int pm, pn; if (!tile_of((long)i * G + c, nM, nN, pm, pn)) return false; if (rev) pm = nM - 1 - pm; const int e = tile_e[pm];
        u.pm = pm; u.pn = pn; u.aux = e; u.aoff = pm * atile; u.boff = e * bstride + pn * btile; return true; }
};
constexpr int SK_NCH = 7, SK_CKT = 4;
DI void sk_split(int nM, int nN, int G, int& R, int& nsp) { const int nu = nM * nN; if (G % nN) { R = (nu + G - 1) / G; nsp = 0; return; } R = nu / G; nsp = (nu - R * G) / nN; }
struct MoeOrderSK {
    int nM, nN, G, c; long atile, btile, bstride; const LAS int* tile_e; long part_off, part_stride, akt; int R, nsp;
    DI void init() { sk_split(nM, nN, G, R, nsp); }
    DI bool next(int i, Unit& u) const {
        if (i < R) { int pm, pn; if (!tile_of((long)i * G + c, nM - nsp, nN, pm, pn)) return false; pm = nM - 1 - pm; const int e = tile_e[pm];
            u.pm = pm; u.pn = pn; u.aux = e; u.kt = 0; u.ooff = 0; u.aoff = pm * atile; u.boff = e * bstride + pn * btile; return true; }
        const int j = (i - R) * G + c; if (j >= nsp * nN * SK_NCH) return false;
        const int ch = j % SK_NCH, q = j / SK_NCH, pn = q % nN, pm = q / nN, e = tile_e[pm]; const long ko = (long)ch * SK_CKT * 128;
        u.pm = pm; u.pn = pn; u.aux = e; u.kt = SK_CKT; u.ooff = ch ? part_off + (ch - 1) * part_stride : 0; u.aoff = pm * atile + (long)ch * SK_CKT * akt; u.boff = e * bstride + pn * btile + ko; return true; }
};

template <class Epi, class Sched, bool FP8 = false, bool NHALF = false>
DI void gemm_phase(LAS unsigned char* lds, const int tid, const Gemm g, const Sched& S, const Epi& E) {
    const int wid = __builtin_amdgcn_readfirstlane(tid >> 6), lane = tid & 63, wr = wid >> 2, wc = wid & 3, fr = lane & 15, fq = lane >> 4;
    const int K = g.K, nt = K / BK;
    unsigned voffA[2], voffB[2];
#pragma unroll
    for (int i = 0; i < 2; ++i) { int R, C; stage_rc(tid * 16 + i * 8192, R, C); const int Rb = Epi::PERM ? ((R & ~31) + perm32(R & 31)) : R;
        voffA[i] = (unsigned)(R * g.lda) * 2u + (unsigned)(C >> 4) * (unsigned)g.a_cs16 + (unsigned)(C & 15) * 2u; voffB[i] = (unsigned)(Rb * g.ldb + C) * 2u; }
    const size_t kstep = (size_t)(BK * 2), kstepA = (size_t)4 * (size_t)g.a_cs16;
    const size_t hsA = (size_t)HALF * g.lda * 2, hsB = NHALF ? (size_t)0 : (size_t)HALF * g.ldb * 2;
    const unsigned ldsw = (unsigned)wid * 1024u;
    const int aoff = lds_byte(wr * 64 + fr, fq * 8), boff = lds_byte(wc * 32 + fr, fq * 8);
#define PG8_SA(b, h) (((b) * 2 + (h)) * HTB)
#define PG8_SB(b, h) ((4 + (b) * 2 + (h)) * HTB)
#define PG8_STAGE(bufoff, gbase, voff) do { _Pragma("unroll") for (int _i = 0; _i < 2; ++_i) \
        __builtin_amdgcn_global_load_lds((const unsigned*)((const char*)(gbase) + (voff)[_i]), (LAS unsigned*)(lds + (bufoff) + ldsw + _i * 8192), 16, 0, 0); } while (0)
#define PG8_LDA(dst, b, h) do { _Pragma("unroll") for (int m = 0; m < 4; ++m) _Pragma("unroll") for (int k = 0; k < 2; ++k) dst[m][k] = *(const LAS bf16x8*)(lds + PG8_SA(b, h) + aoff + m * 2048 + k * 1024); } while (0)
#define PG8_LDB(dst, b, h) do { _Pragma("unroll") for (int n = 0; n < 2; ++n) _Pragma("unroll") for (int k = 0; k < 2; ++k) dst[n][k] = *(const LAS bf16x8*)(lds + PG8_SB(b, h) + boff + n * 2048 + k * 1024); } while (0)
#define PG8_MMA(ai, bj, At, Bt) do { if constexpr (FP8) __builtin_amdgcn_sched_barrier(0); __builtin_amdgcn_s_setprio(1); _Pragma("unroll") for (int m = 0; m < 4; ++m) _Pragma("unroll") for (int n = 0; n < 2; ++n) { \
        if constexpr (FP8) { const i32x8 b8 = __builtin_shufflevector(__builtin_bit_cast(i32x4, Bt[n][0]), __builtin_bit_cast(i32x4, Bt[n][1]), 0, 1, 2, 3, 4, 5, 6, 7), a8 = __builtin_shufflevector(__builtin_bit_cast(i32x4, At[m][0]), __builtin_bit_cast(i32x4, At[m][1]), 0, 1, 2, 3, 4, 5, 6, 7); \
            asm("v_mfma_scale_f32_16x16x128_f8f6f4 %0, %1, %2, %0, %3, %4 op_sel_hi:[0,0,0]" : "+v"(acc[ai][bj][m][n]) : "v"(b8), "v"(a8), "v"(sc_b), "v"(sc_a)); } \
        else { _Pragma("unroll") for (int k = 0; k < 2; ++k) acc[ai][bj][m][n] = __builtin_amdgcn_mfma_f32_16x16x32_bf16(Bt[n][k], At[m][k], acc[ai][bj][m][n], 0, 0, 0); } } __builtin_amdgcn_s_setprio(0); if constexpr (FP8) __builtin_amdgcn_sched_barrier(0); } while (0)
#define PG8_MMA1(ai) do { if constexpr (!NHALF) PG8_MMA(ai, 1, At, B1); } while (0)
#define PG8_WAIT_V(n) asm volatile("s_waitcnt vmcnt(" #n ")" ::: "memory")
#define PG8_WAIT_L(n) asm volatile("s_waitcnt lgkmcnt(" #n ")" ::: "memory")
#define PG8_BAR __builtin_amdgcn_s_barrier()
#define PG8_SCHED __builtin_amdgcn_sched_barrier(0)
    Unit cur, nxt; int ui = 0;
    if (!S.next(0, cur)) return;
    const int sc_b = 121, sc_a = 127;
    f32x4 acc[2][2][4][2];
#pragma unroll
    for (int a = 0; a < 2; ++a)
#pragma unroll
        for (int b = 0; b < 2; ++b)
#pragma unroll
            for (int m = 0; m < 4; ++m)
#pragma unroll
                for (int n = 0; n < 2; ++n) acc[a][b][m][n] = (f32x4){0.f, 0.f, 0.f, 0.f};
    bf16x8 At[4][2], B0[2][2], B1[2][2];
    const char* cA = (const char*)g.A + cur.aoff; const char* cB = (const char*)g.Bt + cur.boff;
    PG8_STAGE(PG8_SB(0, 0), cB, voffB); PG8_STAGE(PG8_SB(0, 1), cB + hsB, voffB); PG8_STAGE(PG8_SA(0, 0), cA, voffA); PG8_STAGE(PG8_SA(0, 1), cA + hsA, voffA);
    if (wr == 1) PG8_BAR;
    PG8_WAIT_V(2); PG8_BAR;
    PG8_STAGE(PG8_SB(1, 0), cB + kstep, voffB); PG8_STAGE(PG8_SA(1, 0), cA + kstepA, voffA); PG8_STAGE(PG8_SB(1, 1), cB + hsB + kstep, voffB);
    PG8_WAIT_V(6); PG8_BAR;
    for (;;) {
        const bool has_next = S.next(ui + 1, nxt);
        const char* nA = has_next ? (const char*)g.A + nxt.aoff : cA; const char* nB = has_next ? (const char*)g.Bt + nxt.boff : cB;
        const int ntu = cur.kt ? cur.kt : nt;
        for (int t = 0; t < ntu; t += 2) {
            const bool last = (t == ntu - 2);
            const char* a1 = cA + (size_t)(t + 1) * kstepA;
            const char* a2 = last ? nA : cA + (size_t)(t + 2) * kstepA; const char* b2 = last ? nB : cB + (size_t)(t + 2) * kstep;
            const char* a3 = a2 + kstepA; const char* b3 = b2 + kstep;
            PG8_LDB(B0, 0, 0); PG8_LDB(B1, 0, 1); PG8_SCHED; PG8_LDA(At, 0, 0); PG8_STAGE(PG8_SA(1, 1), a1 + hsA, voffA);
            PG8_WAIT_V(8); PG8_WAIT_L(0); PG8_BAR; PG8_MMA(0, 0, At, B0); PG8_MMA1(0); PG8_BAR; PG8_SCHED;
            PG8_LDA(At, 0, 1); PG8_STAGE(PG8_SB(0, 0), b2, voffB); PG8_STAGE(PG8_SB(0, 1), b2 + hsB, voffB); PG8_STAGE(PG8_SA(0, 0), a2, voffA);
            PG8_WAIT_V(8); PG8_WAIT_L(0); PG8_BAR; PG8_MMA(1, 0, At, B0); PG8_MMA1(1); PG8_BAR; PG8_SCHED;
            PG8_LDB(B0, 1, 0); PG8_LDB(B1, 1, 1); PG8_SCHED; PG8_LDA(At, 1, 0); PG8_STAGE(PG8_SA(0, 1), a2 + hsA, voffA);
            PG8_WAIT_V(8); PG8_WAIT_L(0); PG8_BAR; PG8_MMA(0, 0, At, B0); PG8_MMA1(0); PG8_BAR; PG8_SCHED;
            PG8_LDA(At, 1, 1); PG8_STAGE(PG8_SB(1, 0), b3, voffB); PG8_STAGE(PG8_SB(1, 1), b3 + hsB, voffB); PG8_STAGE(PG8_SA(1, 0), a3, voffA);
            PG8_WAIT_V(8); PG8_WAIT_L(0); PG8_BAR; PG8_MMA(1, 0, At, B0); PG8_MMA1(1); PG8_BAR; PG8_SCHED;
        }
        if (wr == 0) PG8_BAR;
        if constexpr (FP8) asm volatile("s_nop 15\n\ts_nop 15" ::: "memory");
        { int t2 = tid; asm volatile("" : "+v"(t2)); const int l2 = t2 & 63; E(acc, cur, wr, wc, l2 & 15, l2 >> 4); }
        if (!has_next) break;
#pragma unroll
        for (int a = 0; a < 2; ++a)
#pragma unroll
            for (int b = 0; b < 2; ++b)
#pragma unroll
                for (int m = 0; m < 4; ++m)
#pragma unroll
                    for (int n = 0; n < 2; ++n) acc[a][b][m][n] = (f32x4){0.f, 0.f, 0.f, 0.f};
        cur = nxt; cA = nA; cB = nB; ++ui;
        if (wr == 1) PG8_BAR;
    }
    PG8_WAIT_V(0);
    PG8_BAR;
#undef PG8_SA
#undef PG8_SB
#undef PG8_STAGE
#undef PG8_LDA
#undef PG8_LDB
#undef PG8_MMA
#undef PG8_MMA1
#undef PG8_WAIT_V
#undef PG8_WAIT_L
#undef PG8_BAR
#undef PG8_SCHED
}

typedef const f32x4 (&AccRef)[2][2][4][2];

struct EpiStoreBf16 {
    static constexpr bool PERM = true;
    bf16_t* O; int ldc; const float* bias;
    DI void operator()(AccRef acc, const Unit& u, int wr, int wc, int fr, int fq) const {
        const int row0 = u.pm * BM + wr * 64 + fr, col0 = u.pn * BM + wc * 32 + 8 * fq;
        f32x4 bv[2][2];
#pragma unroll
        for (int bj = 0; bj < 2; ++bj)
#pragma unroll
            for (int n = 0; n < 2; ++n) bv[bj][n] = bias ? *(const f32x4*)(bias + col0 + bj * HALF + 4 * n) : (f32x4){0.f, 0.f, 0.f, 0.f};
#pragma unroll
        for (int ai = 0; ai < 2; ++ai)
#pragma unroll
            for (int m = 0; m < 4; ++m) { bf16_t* rowp = O + u.ooff + (size_t)(row0 + ai * HALF + m * 16) * ldc + col0;
#pragma unroll
                for (int bj = 0; bj < 2; ++bj) { const f32x4 v0 = acc[ai][bj][m][0] + bv[bj][0], v1 = acc[ai][bj][m][1] + bv[bj][1];
                    u32x4 w; w.x = cvt_pk_bf16(v0[0], v0[1]); w.y = cvt_pk_bf16(v0[2], v0[3]); w.z = cvt_pk_bf16(v1[0], v1[1]); w.w = cvt_pk_bf16(v1[2], v1[3]);
                    *(u32x4*)(rowp + bj * HALF) = w; } }
    }
};
struct EpiStoreBf16H {
    static constexpr bool PERM = true;
    static constexpr int NSTORE = 8;
    bf16_t* O; int ldc; const float* bias;
    DI void operator()(AccRef acc, const Unit& u, int wr, int wc, int fr, int fq) const {
        const int row0 = u.pm * BM + wr * 64 + fr, col0 = u.pn * BM + (int)u.ooff + wc * 32 + 8 * fq;
        f32x4 bv[2];
#pragma unroll
        for (int n = 0; n < 2; ++n) bv[n] = bias ? *(const f32x4*)(bias + col0 + 4 * n) : (f32x4){0.f, 0.f, 0.f, 0.f};
#pragma unroll
        for (int ai = 0; ai < 2; ++ai)
#pragma unroll
            for (int m = 0; m < 4; ++m) { const f32x4 v0 = acc[ai][0][m][0] + bv[0], v1 = acc[ai][0][m][1] + bv[1];
                u32x4 w; w.x = cvt_pk_bf16(v0[0], v0[1]); w.y = cvt_pk_bf16(v0[2], v0[3]); w.z = cvt_pk_bf16(v1[0], v1[1]); w.w = cvt_pk_bf16(v1[2], v1[3]);
                *(u32x4*)(O + (size_t)(row0 + ai * HALF + m * 16) * ldc + col0) = w; }
    }
};
struct EpiSwiGLU {
    static constexpr bool PERM = true;
    bf16_t* H; int ldh;
    DI void operator()(AccRef acc, const Unit& u, int wr, int wc, int fr, int fq) const {
        const int row0 = u.pm * BM + wr * 64 + fr, col0 = u.pn * HALF + wc * 32 + 8 * fq;
#pragma unroll
        for (int ai = 0; ai < 2; ++ai)
#pragma unroll
            for (int m = 0; m < 4; ++m) { bf16_t* rowp = H + (size_t)(row0 + ai * HALF + m * 16) * ldh + col0;
                const f32x4 g0 = acc[ai][0][m][0], g1 = acc[ai][0][m][1], u0 = acc[ai][1][m][0], u1 = acc[ai][1][m][1];
                const f32x2 h0 = swiglu2((f32x2){g0[0], g0[1]}, (f32x2){u0[0], u0[1]}), h1 = swiglu2((f32x2){g0[2], g0[3]}, (f32x2){u0[2], u0[3]});
                const f32x2 h2 = swiglu2((f32x2){g1[0], g1[1]}, (f32x2){u1[0], u1[1]}), h3 = swiglu2((f32x2){g1[2], g1[3]}, (f32x2){u1[2], u1[3]});
                u32x4 w; w.x = cvt_pk_bf16(h0.x, h0.y); w.y = cvt_pk_bf16(h1.x, h1.y); w.z = cvt_pk_bf16(h2.x, h2.y); w.w = cvt_pk_bf16(h3.x, h3.y);
                *(u32x4*)rowp = w; }
    }
};
struct EpiSwiGLU8 {
    static constexpr bool PERM = true;
    unsigned char* H; size_t gs;
    DI void operator()(AccRef acc, const Unit& u, int wr, int wc, int fr, int fq) const {
        const int row0 = u.pm * BM + wr * 64 + fr;
        unsigned char* base = H + (size_t)(4 * u.pn + wc) * gs + 8 * fq;
#pragma unroll
        for (int ai = 0; ai < 2; ++ai)
#pragma unroll
            for (int m = 0; m < 4; ++m) { unsigned char* rowp = base + (size_t)(row0 + ai * HALF + m * 16) * 32;
                const f32x4 g0 = acc[ai][0][m][0], g1 = acc[ai][0][m][1], u0 = acc[ai][1][m][0], u1 = acc[ai][1][m][1];
                const f32x2 h0 = swiglu2((f32x2){g0[0], g0[1]}, (f32x2){u0[0], u0[1]}), h1 = swiglu2((f32x2){g0[2], g0[3]}, (f32x2){u0[2], u0[3]});
                const f32x2 h2 = swiglu2((f32x2){g1[0], g1[1]}, (f32x2){u1[0], u1[1]}), h3 = swiglu2((f32x2){g1[2], g1[3]}, (f32x2){u1[2], u1[3]});
                u32x2 w; w.x = cvt4_fp8(h0.x, h0.y, h1.x, h1.y); w.y = cvt4_fp8(h2.x, h2.y, h3.x, h3.y);
                *(u32x2*)rowp = w; }
    }
};
struct EpiResAdd {
    static constexpr bool PERM = true;
    bf16_t* X; const float* bias;
    DI void operator()(AccRef acc, const Unit& u, int wr, int wc, int fr, int fq) const {
        const int row0 = u.pm * BM + wr * 64 + fr, col0 = u.pn * BM + wc * 32 + 8 * fq;
        f32x4 bv[2][2];
#pragma unroll
        for (int bj = 0; bj < 2; ++bj)
#pragma unroll
            for (int n = 0; n < 2; ++n) bv[bj][n] = bias ? *(const f32x4*)(bias + col0 + bj * HALF + 4 * n) : (f32x4){0.f, 0.f, 0.f, 0.f};
        u32x4 xv[2][2];
#define RA_LOAD(r, buf) do { const bf16_t* rp_ = X + (size_t)(row0 + ((r) >> 2) * HALF + ((r) & 3) * 16) * D + col0; \
            _Pragma("unroll") for (int bj = 0; bj < 2; ++bj) xv[buf][bj] = *(const u32x4*)(rp_ + bj * HALF); } while (0)
        RA_LOAD(0, 0);
#pragma unroll
        for (int r = 0; r < 8; ++r) { const int ai = r >> 2, m = r & 3; bf16_t* rowp = X + (size_t)(row0 + ai * HALF + m * 16) * D + col0;
            if (r < 7) RA_LOAD(r + 1, (r + 1) & 1);
#pragma unroll
            for (int bj = 0; bj < 2; ++bj) { const u32x4 xw = xv[r & 1][bj]; const f32x4 a0 = acc[ai][bj][m][0] + bv[bj][0], a1 = acc[ai][bj][m][1] + bv[bj][1];
                u32x4 w; w.x = cvt_pk_bf16(bf_lo(xw.x) + a0[0], bf_hi(xw.x) + a0[1]); w.y = cvt_pk_bf16(bf_lo(xw.y) + a0[2], bf_hi(xw.y) + a0[3]);
                w.z = cvt_pk_bf16(bf_lo(xw.z) + a1[0], bf_hi(xw.z) + a1[1]); w.w = cvt_pk_bf16(bf_lo(xw.w) + a1[2], bf_hi(xw.w) + a1[3]);
                *(u32x4*)(rowp + bj * HALF) = w; }
            asm volatile("" ::: "memory"); }
#undef RA_LOAD
    }
};
struct EpiSloc {
    static constexpr bool PERM = false;
    float* SL;
    DI void operator()(AccRef acc, const Unit& u, int wr, int wc, int fr, int fq) const {
        const int row0 = u.pm * BM + wr * 64 + fr, col0 = wc * 32 + 4 * fq;
#pragma unroll
        for (int ai = 0; ai < 2; ++ai)
#pragma unroll
            for (int m = 0; m < 4; ++m) { float* rowp = SL + ((size_t)u.aux * S5ROWS + row0 + ai * HALF + m * 16) * 128 + col0;
#pragma unroll
                for (int n = 0; n < 2; ++n) *(f32x4*)(rowp + n * 16) = acc[ai][0][m][n]; }
    }
};
struct EpiS5Y {
    static constexpr bool PERM = true;
    bf16_t* Y;
    DI void operator()(AccRef acc, const Unit& u, int wr, int wc, int fr, int fq) const {
        const int g = u.aux, row0 = u.pm * BM + wr * 64 + fr, col0 = u.pn * BM + wc * 32 + 8 * fq, h0 = col0 & 15;
#pragma unroll
        for (int ai = 0; ai < 2; ++ai)
#pragma unroll
            for (int m = 0; m < 4; ++m) { const int R = row0 + ai * HALF + m * 16;
#pragma unroll
                for (int bj = 0; bj < 2; ++bj) { const int c = col0 + bj * HALF, l = c >> 4;
                    const f32x4 a0 = acc[ai][bj][m][0], a1 = acc[ai][bj][m][1];
                    const f32x2 y0 = gelu_tanh2((f32x2){a0[0], a0[1]}), y1 = gelu_tanh2((f32x2){a0[2], a0[3]}), y2 = gelu_tanh2((f32x2){a1[0], a1[1]}), y3 = gelu_tanh2((f32x2){a1[2], a1[3]});
                    u32x4 w; w.x = cvt_pk_bf16(y0.x, y0.y); w.y = cvt_pk_bf16(y1.x, y1.y); w.z = cvt_pk_bf16(y2.x, y2.y); w.w = cvt_pk_bf16(y3.x, y3.y);
                    *(u32x4*)(Y + ((size_t)g * T + (size_t)R * S5C + l) * 16 + h0) = w; } }
    }
};
template <bool XBF>
struct EpiGlu {
    static constexpr bool PERM = true;
    const void* XIN; bf16_t* XOUT; const bf16_t* Y; const float* bias;
    DI void operator()(AccRef acc, const Unit& u, int wr, int wc, int fr, int fq) const {
        const int row0 = u.pm * BM + wr * 64 + fr, col0 = u.pn * BM + wc * 32 + 8 * fq;
        f32x4 bv[2][2];
#pragma unroll
        for (int bj = 0; bj < 2; ++bj)
#pragma unroll
            for (int n = 0; n < 2; ++n) bv[bj][n] = *(const f32x4*)(bias + col0 + bj * HALF + 4 * n);
        f32x4 xf[2][2][2]; u32x4 xb[2][2], yw[2][2];
#define GL_LOAD(r, buf) do { const int row_ = row0 + ((r) >> 2) * HALF + ((r) & 3) * 16; \
            _Pragma("unroll") for (int bj = 0; bj < 2; ++bj) { const int cc = col0 + bj * HALF; \
                if constexpr (XBF) xb[buf][bj] = *(const u32x4*)((const bf16_t*)XIN + (size_t)row_ * D + cc); \
                else { xf[buf][bj][0] = *(const f32x4*)((const float*)XIN + (size_t)row_ * D + cc); xf[buf][bj][1] = *(const f32x4*)((const float*)XIN + (size_t)row_ * D + cc + 4); } \
                yw[buf][bj] = *(const u32x4*)(Y + ((size_t)(cc >> 4) * T + row_) * 16 + (cc & 15)); } } while (0)
        GL_LOAD(0, 0);
#pragma unroll
        for (int r = 0; r < 8; ++r) { const int ai = r >> 2, m = r & 3, b = r & 1; const size_t off = (size_t)(row0 + ai * HALF + m * 16) * D + col0;
            if (r < 7) GL_LOAD(r + 1, (r + 1) & 1);
#pragma unroll
            for (int bj = 0; bj < 2; ++bj) { const f32x4 z0 = acc[ai][bj][m][0] + bv[bj][0], z1 = acc[ai][bj][m][1] + bv[bj][1];
                const f32x2 s0 = sigmoid2((f32x2){z0[0], z0[1]}), s1 = sigmoid2((f32x2){z0[2], z0[3]}), s2 = sigmoid2((f32x2){z1[0], z1[1]}), s3 = sigmoid2((f32x2){z1[2], z1[3]});
                const u32x4 y = yw[b][bj]; f32x2 x0, x1, x2, x3;
                if constexpr (XBF) { const u32x4 x = xb[b][bj]; x0 = (f32x2){bf_lo(x.x), bf_hi(x.x)}; x1 = (f32x2){bf_lo(x.y), bf_hi(x.y)}; x2 = (f32x2){bf_lo(x.z), bf_hi(x.z)}; x3 = (f32x2){bf_lo(x.w), bf_hi(x.w)}; }
                else { const f32x4 xa = xf[b][bj][0], xc = xf[b][bj][1]; x0 = (f32x2){xa[0], xa[1]}; x1 = (f32x2){xa[2], xa[3]}; x2 = (f32x2){xc[0], xc[1]}; x3 = (f32x2){xc[2], xc[3]}; }
                const f32x2 o0 = x0 + (f32x2){bf_lo(y.x), bf_hi(y.x)} * s0, o1 = x1 + (f32x2){bf_lo(y.y), bf_hi(y.y)} * s1, o2 = x2 + (f32x2){bf_lo(y.z), bf_hi(y.z)} * s2, o3 = x3 + (f32x2){bf_lo(y.w), bf_hi(y.w)} * s3;
                *(u32x4*)(XOUT + off + bj * HALF) = (u32x4){cvt_pk_bf16(o0.x, o0.y), cvt_pk_bf16(o1.x, o1.y), cvt_pk_bf16(o2.x, o2.y), cvt_pk_bf16(o3.x, o3.y)}; }
            asm volatile("" ::: "memory"); }
#undef GL_LOAD
    }
};
}

#define XB_TMO      128
#define XB_XCNT(j)  (256  + 64 * (j))
#define XB_XSUB(j)  (1280 + 64 * (j))
#define XB_XGEN(j)  (2304 + 64 * (j))
#define XB_TOP      3328
#define XB_TOPGEN   3392
#define XCD_BAR_WORDS 3456
#define XB_SPIN_CAP (1u << 18)
__device__ __forceinline__ unsigned xb_ld(unsigned* p)              { return __hip_atomic_load(p, __ATOMIC_RELAXED, __HIP_MEMORY_SCOPE_AGENT); }
__device__ __forceinline__ unsigned xb_add(unsigned* p, unsigned v) { return __hip_atomic_fetch_add(p, v, __ATOMIC_RELAXED, __HIP_MEMORY_SCOPE_AGENT); }
__device__ __forceinline__ unsigned xb_xcc_id() { return (unsigned)__builtin_amdgcn_s_getreg((3 << 11) | 20) & 0xFu; }
#define XB_SPIN(cond, bar) do { unsigned _sp = 0; while (cond) { __builtin_amdgcn_s_sleep(1); \
    if ((++_sp & 255u) == 0u) { if (xb_ld(&(bar)[XB_TMO])) break; if (_sp > XB_SPIN_CAP) { atomicAdd(&(bar)[XB_TMO], 1u); break; } } } } while (0)
struct XcdBarrier { unsigned* bar; unsigned x; volatile LAS unsigned* st; };
__device__ __forceinline__ XcdBarrier xcd_barrier_post(unsigned* bar, volatile LAS unsigned* st) {
    XcdBarrier b; b.bar = bar; b.x = xb_xcc_id(); b.st = st;
    if (threadIdx.x == 0) (void)xb_add(&bar[XB_XCNT(b.x)], 1u);
    return b;
}
__device__ __forceinline__ void xcd_barrier_complete(unsigned* bar, unsigned x, unsigned& nloc, unsigned& nx) {
    const unsigned G = gridDim.x * gridDim.y * gridDim.z;
    unsigned sum, cnt, mine, sp = 0u;
    for (;;) {
        sum = 0u; cnt = 0u; mine = 0u;
#pragma unroll
        for (unsigned j = 0; j < 16; ++j) { const unsigned c = xb_ld(&bar[XB_XCNT(j)]); sum += c; cnt += (c > 0u) ? 1u : 0u; mine = (j == x) ? c : mine; }
        if (sum == G) break;
        __builtin_amdgcn_s_sleep(1);
        if ((++sp & 255u) == 0u) { if (xb_ld(&bar[XB_TMO])) break; if (sp > XB_SPIN_CAP) { atomicAdd(&bar[XB_TMO], 1u); break; } }
    }
    nloc = mine > 0u ? mine : 1u; nx = cnt > 0u ? cnt : 1u;
}
__device__ __forceinline__ void xcd_barrier(const XcdBarrier& b) {
    asm volatile("s_waitcnt vmcnt(0)" ::: "memory");
    __syncthreads();
    if (threadIdx.x == 0) {
        unsigned* bar = b.bar;
        __builtin_amdgcn_s_waitcnt(0);
        unsigned nloc = b.st[0], nx = b.st[1];
        if (nloc == 0u) { xcd_barrier_complete(bar, b.x, nloc, nx); b.st[0] = nloc; b.st[1] = nx; }
        const unsigned old = xb_add(&bar[XB_XSUB(b.x)], 1u);
        const unsigned gen = old / nloc;
        if (old + 1u == (gen + 1u) * nloc) {
            __builtin_amdgcn_fence(__ATOMIC_RELEASE, "agent");
            asm volatile("s_waitcnt vmcnt(0)" ::: "memory");
            const unsigned og = xb_add(&bar[XB_TOP], 1u);
            const unsigned tg = og / nx;
            if (og + 1u == (tg + 1u) * nx) xb_add(&bar[XB_TOPGEN], 1u);
            else XB_SPIN(xb_ld(&bar[XB_TOPGEN]) == tg, bar);
            __builtin_amdgcn_fence(__ATOMIC_ACQUIRE, "agent");
            xb_add(&bar[XB_XGEN(b.x)], 1u);
            asm volatile("s_waitcnt vmcnt(0)" ::: "memory");
        } else {
            XB_SPIN(xb_ld(&bar[XB_XGEN(b.x)]) == gen, bar);
            __builtin_amdgcn_fence(__ATOMIC_ACQUIRE, "agent");
            asm volatile("s_waitcnt vmcnt(0)" ::: "memory");
        }
    }
    __syncthreads();
}

struct Frame {
    LAS unsigned char* lds;
    int tid, lane, wave, G, gw, ngw;
};

struct RowId { DI int operator()(int n) const { return n; } };
struct RowGU { int hid; DI int operator()(int n) const { const int up = n >= hid ? 1 : 0, h = n - up * hid; return ((h >> 7) << 8) + (up << 7) + (h & 127); } };
template <bool FP8, class RowMap>
DI void convert_matrix_t(const Frame& F, const float* W, int K, int N, int ldn, void* WTv, int ldk, const RowMap& rm, int nbatch, size_t wstride, size_t tstride) {
    LAS float* scr = (LAS float*)(F.lds + F.wave * 16384);
    const int lane = F.lane, nblk = N / 32, per = (K / 64) * nblk, total = per * nbatch;
    f32x4 v[8];
#define CV_LOAD(it_) do { const int b_ = (it_) / per, r_ = (it_) % per; const float* src_ = W + (size_t)b_ * wstride + (size_t)(64 * (r_ / nblk) + (lane >> 3)) * ldn + 32 * (r_ % nblk) + 4 * (lane & 7); \
        _Pragma("unroll") for (int i = 0; i < 8; ++i) v[i] = *(const f32x4*)(src_ + (size_t)(8 * i) * ldn); } while (0)
    int it = F.gw;
    if (it < total) CV_LOAD(it);
    for (; it < total; it += F.ngw) {
        const int bb = it / per, r = it % per, k0 = 64 * (r / nblk), n0 = 32 * (r % nblk);
        { LAS float* dst = scr + (lane >> 3) * 33 + 4 * (lane & 7);
#pragma unroll
          for (int i = 0; i < 8; ++i) { dst[(8 * i) * 33 + 0] = v[i][0]; dst[(8 * i) * 33 + 1] = v[i][1]; dst[(8 * i) * 33 + 2] = v[i][2]; dst[(8 * i) * 33 + 3] = v[i][3]; } }
        asm volatile("" ::: "memory");
        if (it + F.ngw < total) CV_LOAD(it + F.ngw);
        LDS_WAIT(); asm volatile("" ::: "memory");
        const int c = lane & 7;
#pragma unroll
        for (int j = 0; j < 4; ++j) { const int n = (lane >> 3) + 8 * j; const LAS float* s = scr + (8 * c) * 33 + n;
            if constexpr (FP8) { u32x2 o; o.x = cvt4_fp8(s[0 * 33] * W8_SCALE, s[1 * 33] * W8_SCALE, s[2 * 33] * W8_SCALE, s[3 * 33] * W8_SCALE); o.y = cvt4_fp8(s[4 * 33] * W8_SCALE, s[5 * 33] * W8_SCALE, s[6 * 33] * W8_SCALE, s[7 * 33] * W8_SCALE);
                *(u32x2*)((unsigned char*)WTv + (size_t)bb * tstride + (size_t)rm(n0 + n) * ldk + k0 + 8 * c) = o; }
            else { u32x4 o; o.x = cvt_pk_bf16(s[0 * 33], s[1 * 33]); o.y = cvt_pk_bf16(s[2 * 33], s[3 * 33]); o.z = cvt_pk_bf16(s[4 * 33], s[5 * 33]); o.w = cvt_pk_bf16(s[6 * 33], s[7 * 33]);
                *(u32x4*)((bf16_t*)WTv + (size_t)bb * tstride + (size_t)rm(n0 + n) * ldk + k0 + 8 * c) = o; } }
        LDS_WAIT(); asm volatile("" ::: "memory");
    }
#undef CV_LOAD
}
template <class RowMap>
DI void convert_matrix(const Frame& F, const float* W, int K, int N, int ldn, bf16_t* WT, int ldk, const RowMap& rm, int nbatch, size_t wstride, size_t tstride) { convert_matrix_t<false>(F, W, K, N, ldn, WT, ldk, rm, nbatch, wstride, tstride); }
template <class RowMap>
DI void convert_matrix8(const Frame& F, const float* W, int K, int N, int ldn, unsigned char* WT, int ldk, const RowMap& rm, int nbatch, size_t wstride, size_t tstride) { convert_matrix_t<true>(F, W, K, N, ldn, WT, ldk, rm, nbatch, wstride, tstride); }

DI void load_row(const float* xrow, int lane, f32x4 (&v)[4]) {
#pragma unroll
    for (int j = 0; j < 4; ++j) v[j] = *(const f32x4*)(xrow + 4 * lane + 256 * j);
}
DI void load_row(const bf16_t* xrow, int lane, f32x4 (&v)[4]) {
#pragma unroll
    for (int j = 0; j < 4; ++j) { const u32x2 w = *(const u32x2*)(xrow + 4 * lane + 256 * j); v[j] = (f32x4){bf_lo(w.x), bf_hi(w.x), bf_lo(w.y), bf_hi(w.y)}; }
}
DI float row_rstd(const f32x4 (&v)[4]) {
    float s = 0.f;
#pragma unroll
    for (int j = 0; j < 4; ++j) s += (v[j][0] * v[j][0] + v[j][1] * v[j][1]) + (v[j][2] * v[j][2] + v[j][3] * v[j][3]);
    return rsqrtf(wave_sum(s) * (1.f / D) + EPS);
}
template <bool FP8 = false>
DI void norm_phase(const Frame& F, const bf16_t* X, const float* gain, bf16_t* XN) {
    f32x4 gv[4]; load_row(gain, F.lane, gv);
    f32x4 vn[4]; if (F.gw < T) load_row(X + (size_t)F.gw * D, F.lane, vn);
    for (int t = F.gw; t < T; t += F.ngw) {
        f32x4 v[4];
#pragma unroll
        for (int j = 0; j < 4; ++j) v[j] = vn[j];
        if (t + F.ngw < T) load_row(X + (size_t)(t + F.ngw) * D, F.lane, vn);
        const float rs = row_rstd(v);
#pragma unroll
        for (int j = 0; j < 4; ++j) {
            if constexpr (FP8) { *(unsigned*)((unsigned char*)XN + (size_t)t * D + 4 * F.lane + 256 * j) = cvt4_fp8(v[j][0] * rs * gv[j][0], v[j][1] * rs * gv[j][1], v[j][2] * rs * gv[j][2], v[j][3] * rs * gv[j][3]); }
            else { u32x2 w; w.x = cvt_pk_bf16(v[j][0] * rs * gv[j][0], v[j][1] * rs * gv[j][1]); w.y = cvt_pk_bf16(v[j][2] * rs * gv[j][2], v[j][3] * rs * gv[j][3]);
                *(u32x2*)(XN + (size_t)t * D + 4 * F.lane + 256 * j) = w; } }
    }
}
template <class XT>
DI void norm_to_ug_phase(const Frame& F, const XT* X, const float* gain, bf16_t* UG, bf16_t* XB) {
    f32x4 gv[4];
#pragma unroll
    for (int j = 0; j < 4; ++j) gv[j] = *(const f32x4*)(gain + 16 * F.lane + 4 * j);
    constexpr int NCH = T / S5C, TS = 2080;
    LAS unsigned char* st = F.lds;
    for (int ch = blockIdx.x; ch < NCH; ch += F.G) {
        f32x4 v[4][4];
#pragma unroll
        for (int i = 0; i < 4; ++i)
#pragma unroll
            for (int j = 0; j < 4; ++j) { const XT* src = X + (size_t)(ch * S5C + 4 * F.wave + i) * D + 16 * F.lane + 4 * j;
                if constexpr (sizeof(XT) == 4) v[i][j] = *(const f32x4*)src; else { const u32x2 w = *(const u32x2*)src; v[i][j] = (f32x4){bf_lo(w.x), bf_hi(w.x), bf_lo(w.y), bf_hi(w.y)}; } }
#pragma unroll
        for (int i = 0; i < 4; ++i) { const float rs = row_rstd(v[i]); unsigned w[8];
#pragma unroll
            for (int j = 0; j < 4; ++j) { w[2 * j] = cvt_pk_bf16(v[i][j][0] * rs * gv[j][0], v[i][j][1] * rs * gv[j][1]); w[2 * j + 1] = cvt_pk_bf16(v[i][j][2] * rs * gv[j][2], v[i][j][3] * rs * gv[j][3]); }
            if constexpr (sizeof(XT) == 4) { bf16_t* xb = XB + (size_t)(ch * S5C + 4 * F.wave + i) * D + 16 * F.lane;
                *(u32x4*)xb = (u32x4){cvt_pk_bf16(v[i][0][0], v[i][0][1]), cvt_pk_bf16(v[i][0][2], v[i][0][3]), cvt_pk_bf16(v[i][1][0], v[i][1][1]), cvt_pk_bf16(v[i][1][2], v[i][1][3])};
                *(u32x4*)(xb + 8) = (u32x4){cvt_pk_bf16(v[i][2][0], v[i][2][1]), cvt_pk_bf16(v[i][2][2], v[i][2][3]), cvt_pk_bf16(v[i][3][0], v[i][3][1]), cvt_pk_bf16(v[i][3][2], v[i][3][3])}; }
            LAS unsigned char* dl = st + (4 * F.wave + i) * TS + F.lane * 32;
            *(LAS u32x4*)dl = (u32x4){w[0], w[1], w[2], w[3]}; *(LAS u32x4*)(dl + 16) = (u32x4){w[4], w[5], w[6], w[7]}; }
        __syncthreads();
#pragma unroll
        for (int k = 0; k < 8; ++k) { const int g = 8 * F.wave + k;
            const u32x4 o = *(const LAS u32x4*)(st + (F.lane >> 1) * TS + g * 32 + (F.lane & 1) * 16);
            *(u32x4*)(UG + ((size_t)g * S5ROWS + ch) * S5LD + 8 * F.lane) = o; }
        __syncthreads();
    }
}

struct S5P { const float *lam_re, *lam_im, *log_dt, *b_re, *b_im, *c_re, *c_im, *dskip, *w_glu, *b_glu; };
DI void s5_tables_phase(const Frame& F, const S5P& p, bf16_t* TG, bf16_t* FG) {
    LAS f32x2* pw = (LAS f32x2*)(F.lds);
    LAS f32x2* bb = (LAS f32x2*)(F.lds + 16896);
    LAS f32x2* cc = (LAS f32x2*)(F.lds + 25088);
    LAS float* kt = (LAS float*)(F.lds + 33280);
    LAS f32x2* cct = (LAS f32x2*)(F.lds + 67584);
    const int tid = F.tid;
    for (int unit = blockIdx.x; unit < 256; unit += F.G) {
        const int g = unit >> 2, q = unit & 3;
        const float dt = expf(p.log_dt[g]);
        for (int i = tid; i < 33 * 64; i += NTHR) { const int tau = i >> 6, pp = i & 63; const float lre = p.lam_re[g * 64 + pp], lim = p.lam_im[g * 64 + pp];
            const float mag = __expf((float)tau * dt * lre), rev = __builtin_amdgcn_fractf((float)tau * (dt * lim * 0.15915494309189535f)); pw[i] = (f32x2){mag * __builtin_amdgcn_cosf(rev), mag * __builtin_amdgcn_sinf(rev)}; }
        for (int i = tid; i < 1024; i += NTHR) { const int pp = i >> 4, hi = i & 15; const float lre = p.lam_re[g * 64 + pp], lim = p.lam_im[g * 64 + pp];
            const float mag = __expf(dt * lre), rev = __builtin_amdgcn_fractf(dt * lim * 0.15915494309189535f), nr = mag * __builtin_amdgcn_cosf(rev) - 1.f, ni = mag * __builtin_amdgcn_sinf(rev), den = __builtin_amdgcn_rcpf(lre * lre + lim * lim);
            const float cr = (nr * lre + ni * lim) * den, ci = (ni * lre - nr * lim) * den;
            const float br = p.b_re[(size_t)(g * 64 + pp) * 16 + hi], bi = p.b_im[(size_t)(g * 64 + pp) * 16 + hi];
            bb[i] = (f32x2){cr * br - ci * bi, cr * bi + ci * br}; }
        for (int i = tid; i < 1024; i += NTHR) { const int ho = i >> 6, pp = i & 63; const f32x2 cv = (f32x2){p.c_re[(size_t)(g * 16 + ho) * 64 + pp], p.c_im[(size_t)(g * 16 + ho) * 64 + pp]}; cc[i] = cv; cct[pp * 16 + ho] = cv; }
        __syncthreads();
        {
          const int tau = tid >> 4, ho0 = ((tid >> 2) & 3) * 4, hi0 = (tid & 3) * 4;
          float acc[4][4];
#pragma unroll
          for (int i = 0; i < 4; ++i)
#pragma unroll
              for (int j = 0; j < 4; ++j) acc[i][j] = 0.f;
#pragma unroll 2
          for (int pp = 0; pp < 64; ++pp) { const f32x2 a = pw[tau * 64 + pp];
              const f32x4 b01 = *(const LAS f32x4*)(bb + pp * 16 + hi0), b23 = *(const LAS f32x4*)(bb + pp * 16 + hi0 + 2);
              const float br[4] = {b01[0], b01[2], b23[0], b23[2]}, bi[4] = {b01[1], b01[3], b23[1], b23[3]};
              const f32x4 c01 = *(const LAS f32x4*)(cct + pp * 16 + ho0), c23 = *(const LAS f32x4*)(cct + pp * 16 + ho0 + 2);
              const float cr[4] = {c01[0], c01[2], c23[0], c23[2]}, ci[4] = {c01[1], c01[3], c23[1], c23[3]};
#pragma unroll
              for (int i = 0; i < 4; ++i) { const float zr = cr[i] * a.x - ci[i] * a.y, zi = cr[i] * a.y + ci[i] * a.x;
#pragma unroll
                  for (int j = 0; j < 4; ++j) acc[i][j] += zr * br[j] - zi * bi[j]; } }
          if (tau == 0 && ho0 == hi0) {
#pragma unroll
              for (int i = 0; i < 4; ++i) acc[i][i] += p.dskip[g * 16 + ho0 + i]; }
#pragma unroll
          for (int i = 0; i < 4; ++i) *(LAS f32x4*)(kt + tau * 264 + (ho0 + i) * 16 + hi0) = (f32x4){acc[i][0], acc[i][1], acc[i][2], acc[i][3]}; }
        __syncthreads();
        for (int nl = F.wave; nl < 128; nl += NWAVES) for (int ck = F.lane; ck < 80; ck += 64) { const int n = 128 * q + nl, l = n >> 4, ho = n & 15, k0 = 8 * ck; float v[8];
            if (k0 < S5K) { const int lp = k0 >> 4, hi0 = k0 & 15;
#pragma unroll
                for (int j = 0; j < 8; ++j) v[j] = (lp <= l) ? kt[(l - lp) * 264 + ho * 16 + hi0 + j] : 0.f; }
            else if (k0 < S5K + 64) { const int p0 = k0 - S5K;
#pragma unroll
                for (int j = 0; j < 8; ++j) { const f32x2 c = cc[ho * 64 + p0 + j], a = pw[(l + 1) * 64 + p0 + j]; v[j] = c.x * a.x - c.y * a.y; } }
            else { const int p0 = k0 - S5K - 64;
#pragma unroll
                for (int j = 0; j < 8; ++j) { const f32x2 c = cc[ho * 64 + p0 + j], a = pw[(l + 1) * 64 + p0 + j]; v[j] = -(c.x * a.y + c.y * a.x); } }
            *(u32x4*)(TG + ((size_t)g * S5K + n) * S5LD + k0) = (u32x4){cvt_pk_bf16(v[0], v[1]), cvt_pk_bf16(v[2], v[3]), cvt_pk_bf16(v[4], v[5]), cvt_pk_bf16(v[6], v[7])}; }
        for (int ch = tid; ch < 32 * 64; ch += NTHR) { const int nl = ch >> 6, ck = ch & 63, n = 32 * q + nl, pp = n & 63, k0 = 8 * ck, lp = k0 >> 4, hi0 = k0 & 15, tau = S5C - 1 - lp; float v[8];
            const f32x2 a = pw[tau * 64 + pp];
#pragma unroll
            for (int j = 0; j < 8; ++j) { const f32x2 b = bb[pp * 16 + hi0 + j]; v[j] = (n < 64) ? (a.x * b.x - a.y * b.y) : (a.x * b.y + a.y * b.x); }
            *(u32x4*)(FG + ((size_t)g * 256 + n) * S5K + k0) = (u32x4){cvt_pk_bf16(v[0], v[1]), cvt_pk_bf16(v[2], v[3]), cvt_pk_bf16(v[4], v[5]), cvt_pk_bf16(v[6], v[7])}; }
        __syncthreads();
    }
}
DI void s5_scan_tile(const Frame& F, const S5P& p, const float* SLOC, bf16_t* UG, int g, int pm) {
    if (F.tid < 256) {
        const int pp = F.tid & 63, b = 4 * pm + (F.tid >> 6);
        const float dt = expf(p.log_dt[g]), lre = p.lam_re[g * 64 + pp], lim = p.lam_im[g * 64 + pp];
        const float mag = __expf((float)S5C * dt * lre), rev = __builtin_amdgcn_fractf((float)S5C * (dt * lim * 0.15915494309189535f)), ar = mag * __builtin_amdgcn_cosf(rev), ai = mag * __builtin_amdgcn_sinf(rev);
        float sr = 0.f, si = 0.f;
        const int nch = SEQ / S5C;
#pragma unroll 16
        for (int c = 0; c < nch; ++c) { const size_t R = (size_t)g * S5ROWS + b * nch + c;
            UG[R * S5LD + S5K + pp] = f2bf(sr); UG[R * S5LD + S5K + 64 + pp] = f2bf(si);
            const float lr = SLOC[R * 128 + pp], li = SLOC[R * 128 + 64 + pp];
            const float nr = ar * sr - ai * si + lr, ni = ar * si + ai * sr + li; sr = nr; si = ni; }
    }
}
DI void s5_scan_phase(const Frame& F, const S5P& p, const float* SLOC, bf16_t* UG) {
    const int gt = blockIdx.x * NTHR + F.tid, nth = F.G * NTHR;
    for (int id = gt; id < 64 * BATCH * 64; id += nth) {
        const int pp = id & 63, b = (id >> 6) & 15, g = id >> 10;
        const float dt = expf(p.log_dt[g]), lre = p.lam_re[g * 64 + pp], lim = p.lam_im[g * 64 + pp];
        const float mag = __expf((float)S5C * dt * lre), rev = __builtin_amdgcn_fractf((float)S5C * (dt * lim * 0.15915494309189535f)), ar = mag * __builtin_amdgcn_cosf(rev), ai = mag * __builtin_amdgcn_sinf(rev);
        float sr = 0.f, si = 0.f;
        const int nch = SEQ / S5C;
#pragma unroll 16
        for (int c = 0; c < nch; ++c) { const size_t R = (size_t)g * S5ROWS + b * nch + c;
            UG[R * S5LD + S5K + pp] = f2bf(sr); UG[R * S5LD + S5K + 64 + pp] = f2bf(si);
            const float lr = SLOC[R * 128 + pp], li = SLOC[R * 128 + 64 + pp];
            const float nr = ar * sr - ai * si + lr, ni = ar * si + ai * sr + li; sr = nr; si = ni; }
    }
}

DI void gla_prep_phase(const Frame& F, const bf16_t* PROJ, const float* wg2, const float* bg2, bf16_t* QSB, bf16_t* KE, bf16_t* SCB, float* DECG) {
    constexpr int QS = 0, KS = 17408, KET = 34816, SC = 53248, VT = 62464, GLOW = 99328, WG2 = 103424, QSUM = 111616, BG = 113664;
    LAS unsigned char* lds = F.lds;
    const int tid = F.tid, lane = F.lane, w = F.wave, q4 = lane >> 4, r16 = lane & 15;
    const int d = tid & 127, tq = __builtin_amdgcn_readfirstlane(tid >> 7);
    int hprev = -1;
    u32x4 pq[2], pk[2], pg; pg = (u32x4){0u, 0u, 0u, 0u};
#define GLP_ISSUE(uu) do { const int h_ = (uu) & 3; const size_t tk0 = (size_t)((uu) >> 7) * SEQ + (((uu) >> 2) & 31) * 64; \
        _Pragma("unroll") for (int i = 0; i < 2; ++i) { const int id = tid + NTHR * i; const bf16_t* src = PROJ + (tk0 + (id >> 4)) * GLA_N + h_ * 128 + (id & 15) * 8; pq[i] = *(const u32x4*)src; pk[i] = *(const u32x4*)(src + 512); } \
        if (tid < 128) pg = *(const u32x4*)(PROJ + (tk0 + (tid >> 1)) * GLA_N + 3072 + (tid & 1) * 8); } while (0)
    if ((int)blockIdx.x < 2048) GLP_ISSUE((int)blockIdx.x);
    for (int u = blockIdx.x; u < 2048; u += F.G) {
        const int h = u & 3;
        if (h != hprev) { for (int i = tid; i < 2048; i += NTHR) ((LAS float*)(lds + WG2))[i] = wg2[(i >> 7) * 512 + h * 128 + (i & 127)];
            if (tid < 128) ((LAS float*)(lds + BG))[tid] = bg2[h * 128 + tid]; hprev = h; }
#pragma unroll
        for (int i = 0; i < 2; ++i) { const int id = tid + NTHR * i, row = id >> 4, c8 = id & 15; *(LAS u32x4*)(lds + QS + row * 272 + c8 * 16) = pq[i]; *(LAS u32x4*)(lds + KS + row * 272 + c8 * 16) = pk[i]; }
        if (tid < 128) { const int row = tid >> 1, hf = tid & 1; LAS float* gl = (LAS float*)(lds + GLOW) + row * 16 + hf * 8;
            gl[0] = bf_lo(pg.x); gl[1] = bf_hi(pg.x); gl[2] = bf_lo(pg.y); gl[3] = bf_hi(pg.y); gl[4] = bf_lo(pg.z); gl[5] = bf_hi(pg.z); gl[6] = bf_lo(pg.w); gl[7] = bf_hi(pg.w); }
        LDS_BARRIER();
        if (u + F.G < 2048) GLP_ISSUE(u + F.G);
        float cum[16];
        { float wcol[16];
#pragma unroll
          for (int r = 0; r < 16; ++r) wcol[r] = ((LAS float*)(lds + WG2))[r * 128 + d];
          const float bcol = ((LAS float*)(lds + BG))[d]; float run = 0.f;
#pragma unroll
          for (int i = 0; i < 16; ++i) { const LAS f32x4* gl = (const LAS f32x4*)(lds + GLOW + (tq * 16 + i) * 64); float z = bcol;
#pragma unroll
              for (int r4 = 0; r4 < 4; ++r4) { const f32x4 gq = gl[r4]; z += gq[0] * wcol[4 * r4] + gq[1] * wcol[4 * r4 + 1] + gq[2] * wcol[4 * r4 + 2] + gq[3] * wcol[4 * r4 + 3]; }
              const float ls = fminf(z, 0.f) - __logf(1.f + __expf(-fabsf(z))); run += ls * (1.f / 16.f); cum[i] = run; }
          ((LAS float*)(lds + QSUM))[tq * 128 + d] = run; }
        LDS_BARRIER();
        { float off = 0.f, glast = 0.f;
#pragma unroll
          for (int t4 = 0; t4 < 4; ++t4) { const float qv = ((LAS float*)(lds + QSUM))[t4 * 128 + d]; glast += qv; if (t4 < tq) off += qv; }
          const float dec = __expf(glast);
          unsigned ke[8];
#pragma unroll
          for (int i = 0; i < 16; i += 2) { float kend[2];
#pragma unroll
              for (int ii = 0; ii < 2; ++ii) { const int tok = tq * 16 + i + ii; const float eg = __expf(off + cum[i + ii]), eng = __builtin_amdgcn_rcpf(eg);
                  LAS bf16_t* qp = (LAS bf16_t*)(lds + QS + tok * 272 + d * 2); LAS bf16_t* kp = (LAS bf16_t*)(lds + KS + tok * 272 + d * 2);
                  const float qv = bf2f(*qp), ks = bf2f(*kp) * eng;
                  *qp = f2bf(qv * 0.08838834764831845f * eg); *kp = f2bf(ks); kend[ii] = ks * dec; }
              ke[i >> 1] = cvt_pk_bf16(kend[0], kend[1]); }
          *(LAS u32x4*)(lds + KET + d * 144 + tq * 32) = (u32x4){ke[0], ke[1], ke[2], ke[3]}; *(LAS u32x4*)(lds + KET + d * 144 + tq * 32 + 16) = (u32x4){ke[4], ke[5], ke[6], ke[7]};
          if (tq == 0) DECG[(size_t)u * 128 + d] = dec; }
        LDS_BARRIER();
        { const int it = w >> 1;
#pragma unroll
          for (int jj = 0; jj < 2; ++jj) { const int jt = 2 * (w & 1) + jj; f32x4 a = (f32x4){0.f, 0.f, 0.f, 0.f};
              if (jt <= it) {
#pragma unroll
                  for (int ks = 0; ks < 4; ++ks) { const bf16x8 af = *(const LAS bf16x8*)(lds + QS + (16 * it + r16) * 272 + (ks * 32 + q4 * 8) * 2), bfr = *(const LAS bf16x8*)(lds + KS + (16 * jt + r16) * 272 + (ks * 32 + q4 * 8) * 2);
                      a = __builtin_amdgcn_mfma_f32_16x16x32_bf16(af, bfr, a, 0, 0, 0); } }
#pragma unroll
              for (int rr = 0; rr < 4; ++rr) { const int i = 16 * it + 4 * q4 + rr, j = 16 * jt + r16; *(LAS bf16_t*)(lds + SC + i * 144 + j * 2) = f2bf(j <= i ? a[rr] : 0.f); } } }
        LDS_BARRIER();
#pragma unroll
        for (int i = 0; i < 2; ++i) { const int id = tid + NTHR * i, row = id >> 4, c8 = id & 15; *(u32x4*)(QSB + (size_t)u * 8192 + (size_t)id * 8) = *(const LAS u32x4*)(lds + QS + row * 272 + c8 * 16); }
#pragma unroll
        for (int i = 0; i < 2; ++i) { const int id = tid + NTHR * i, row = id >> 3, c8 = id & 7; *(u32x4*)(KE + (size_t)u * 8192 + (size_t)id * 8) = *(const LAS u32x4*)(lds + KET + row * 144 + c8 * 16); }
        { const int row = tid >> 3, c8 = tid & 7; *(u32x4*)(SCB + (size_t)u * 4096 + (size_t)tid * 8) = *(const LAS u32x4*)(lds + SC + row * 144 + c8 * 16); }
        LDS_BARRIER();
    }
#undef GLP_ISSUE
}
DI void gla_seq_phase(const Frame& F, const bf16_t* QSB, const bf16_t* KE, const bf16_t* SCB, const bf16_t* PROJ, const float* DECG, bf16_t* GO) {
    constexpr int BUF = 54784, QS = 0, KET = 17408, VT = 35840, SC = 45056, DEC = 54272, ST0 = 2 * BUF, STB = 17408;
    LAS unsigned char* lds = F.lds;
    const int tid = F.tid, lane = F.lane, w = F.wave, q4 = lane >> 4, r16 = lane & 15;
    const int vtb = (8 * q4 + ((lane >> 2) & 3)) * 144 + (lane & 3) * 8;
    for (int ui = blockIdx.x; ui < 256; ui += F.G) {
        const int unit = (F.G == 256) ? (((ui & 7) << 5) | (ui >> 3)) : ui;
        const int b = unit >> 4, h = (unit >> 2) & 3, s = unit & 3;
        for (int i = tid; i < STB / 4; i += NTHR) ((LAS unsigned*)(lds + ST0))[i] = 0u;
        f32x4 st[4];
#pragma unroll
        for (int e = 0; e < 4; ++e) st[e] = (f32x4){0.f, 0.f, 0.f, 0.f};
        u32x4 rA[7], rB[7];
        rA[6] = (u32x4){0u, 0u, 0u, 0u}; rB[6] = (u32x4){0u, 0u, 0u, 0u};
#define GLA_ISSUE(R, nn) do { const size_t uu = (size_t)b * 128 + (nn) * 4 + h; \
            _Pragma("unroll") for (int i = 0; i < 2; ++i) { const int id = tid + NTHR * i; R[i] = *(const u32x4*)(QSB + uu * 8192 + (size_t)id * 8); R[2 + i] = *(const u32x4*)(KE + uu * 8192 + (size_t)id * 8); } \
            R[4] = *(const u32x4*)(PROJ + ((size_t)b * SEQ + (nn) * 64 + (tid >> 3)) * GLA_N + 1024 + h * 256 + s * 64 + (tid & 7) * 8); R[5] = *(const u32x4*)(SCB + uu * 4096 + (size_t)tid * 8); \
            if (tid < 32) R[6] = *(const u32x4*)(DECG + uu * 128 + tid * 4); } while (0)
#define GLA_TO_LDS(R, bufb) do { _Pragma("unroll") for (int i = 0; i < 2; ++i) { const int id = tid + NTHR * i; *(LAS u32x4*)((bufb) + QS + (id >> 4) * 272 + (id & 15) * 16) = R[i]; *(LAS u32x4*)((bufb) + KET + (id >> 3) * 144 + (id & 7) * 16) = R[2 + i]; } \
            *(LAS u32x4*)((bufb) + VT + (tid >> 3) * 144 + (tid & 7) * 16) = R[4]; *(LAS u32x4*)((bufb) + SC + (tid >> 3) * 144 + (tid & 7) * 16) = R[5]; \
            if (tid < 32) *(LAS u32x4*)((bufb) + DEC + tid * 16) = R[6]; } while (0)
#define GLA_VTR(bufb_, et_, ks_) __builtin_shufflevector(__builtin_amdgcn_ds_read_tr16_b64_v4i16((LAS s16x4*)((bufb_) + VT + vtb + (ks_) * (32 * 144) + (et_) * 32)), \
            __builtin_amdgcn_ds_read_tr16_b64_v4i16((LAS s16x4*)((bufb_) + VT + vtb + (ks_) * (32 * 144) + (et_) * 32 + 4 * 144)), 0, 1, 2, 3, 4, 5, 6, 7)
#define GLA_STEP(n) do { const size_t tok0 = (size_t)b * SEQ + (n) * 64; \
            const LAS unsigned char* bufb = lds + ((n) & 1) * BUF; const LAS unsigned char* stc = lds + ST0 + ((n) & 1) * STB; LAS unsigned char* stn = lds + ST0 + (((n) + 1) & 1) * STB; \
            const int fo = q4 * 16; \
            { const int tt = w >> 1; bf16x8 bs[2], bq[4]; \
              _Pragma("unroll") for (int ks = 0; ks < 2; ++ks) bs[ks] = *(const LAS bf16x8*)(bufb + SC + (16 * tt + r16) * 144 + ks * 64 + fo); \
              _Pragma("unroll") for (int ks = 0; ks < 4; ++ks) bq[ks] = *(const LAS bf16x8*)(bufb + QS + (16 * tt + r16) * 272 + ks * 64 + fo); \
              _Pragma("unroll") for (int ee = 0; ee < 2; ++ee) { const int et = 2 * (w & 1) + ee; f32x4 a = (f32x4){0.f, 0.f, 0.f, 0.f}; \
                  _Pragma("unroll") for (int ks = 0; ks < 2; ++ks) { const bf16x8 av = GLA_VTR(bufb, et, ks); a = __builtin_amdgcn_mfma_f32_16x16x32_bf16(av, bs[ks], a, 0, 0, 0); } \
                  _Pragma("unroll") for (int ks = 0; ks < 4; ++ks) { const bf16x8 as = *(const LAS bf16x8*)(stc + (16 * et + r16) * 272 + ks * 64 + fo); a = __builtin_amdgcn_mfma_f32_16x16x32_bf16(as, bq[ks], a, 0, 0, 0); } \
                  *(u32x2*)(GO + (tok0 + 16 * tt + r16) * D + h * 256 + s * 64 + 16 * et + 4 * q4) = (u32x2){cvt_pk_bf16(a[0], a[1]), cvt_pk_bf16(a[2], a[3])}; } } \
            { bf16x8 ak[2]; \
              _Pragma("unroll") for (int ks = 0; ks < 2; ++ks) ak[ks] = *(const LAS bf16x8*)(bufb + KET + (16 * w + r16) * 144 + ks * 64 + fo); \
              const f32x4 dec = *(const LAS f32x4*)(bufb + DEC + (16 * w + 4 * q4) * 4); \
              _Pragma("unroll") for (int et = 0; et < 4; ++et) { st[et] = st[et] * dec; \
                  _Pragma("unroll") for (int ks = 0; ks < 2; ++ks) { const bf16x8 bv = GLA_VTR(bufb, et, ks); st[et] = __builtin_amdgcn_mfma_f32_16x16x32_bf16(ak[ks], bv, st[et], 0, 0, 0); } \
                  *(LAS u32x2*)(stn + (16 * et + r16) * 272 + (16 * w + 4 * q4) * 2) = (u32x2){cvt_pk_bf16(st[et][0], st[et][1]), cvt_pk_bf16(st[et][2], st[et][3])}; } } } while (0)
        GLA_ISSUE(rA, 0); GLA_ISSUE(rB, 1); GLA_TO_LDS(rA, lds); GLA_ISSUE(rA, 2);
        LDS_BARRIER();
        for (int n = 0; n < 32; n += 2) {
            asm volatile("" ::: "memory");
            GLA_STEP(n);
            GLA_TO_LDS(rB, lds + BUF);
            if (n + 3 < 32) GLA_ISSUE(rB, n + 3);
            LDS_BARRIER();
            asm volatile("" ::: "memory");
            GLA_STEP(n + 1);
            if (n + 2 < 32) { GLA_TO_LDS(rA, lds); }
            if (n + 4 < 32) GLA_ISSUE(rA, n + 4);
            LDS_BARRIER();
        }
#undef GLA_ISSUE
#undef GLA_TO_LDS
#undef GLA_STEP
#undef GLA_VTR
    }
}
DI void gla_finalize_phase(const Frame& F, const bf16_t* GO, const bf16_t* PROJ, const float* gnorm, bf16_t* OG) {
    f32x4 gv[4];
#pragma unroll
    for (int j = 0; j < 4; ++j) gv[j] = *(const f32x4*)(gnorm + 16 * F.lane + 4 * j);
    for (int t = F.gw; t < T; t += F.ngw) {
        const u32x4 o0 = *(const u32x4*)(GO + (size_t)t * D + 16 * F.lane), o1 = *(const u32x4*)(GO + (size_t)t * D + 16 * F.lane + 8);
        const u32x4 r0 = *(const u32x4*)(PROJ + (size_t)t * GLA_N + 2048 + 16 * F.lane), r1 = *(const u32x4*)(PROJ + (size_t)t * GLA_N + 2048 + 16 * F.lane + 8);
        const unsigned ow[8] = {o0.x, o0.y, o0.z, o0.w, o1.x, o1.y, o1.z, o1.w}, rw[8] = {r0.x, r0.y, r0.z, r0.w, r1.x, r1.y, r1.z, r1.w};
        float o[16], ss = 0.f;
#pragma unroll
        for (int j = 0; j < 8; ++j) { o[2 * j] = bf_lo(ow[j]); o[2 * j + 1] = bf_hi(ow[j]); ss += o[2 * j] * o[2 * j] + o[2 * j + 1] * o[2 * j + 1]; }
        ss += __shfl_xor(ss, 1); ss += __shfl_xor(ss, 2); ss += __shfl_xor(ss, 4); ss += __shfl_xor(ss, 8);
        const float rs = rsqrtf(ss * (1.f / 256.f) + EPS);
        unsigned w[8];
#pragma unroll
        for (int j = 0; j < 8; ++j) { const float ra = bf_lo(rw[j]), rb = bf_hi(rw[j]); w[j] = cvt_pk_bf16(o[2 * j] * rs * gv[j >> 1][(2 * j) & 3] * silu_f(ra), o[2 * j + 1] * rs * gv[j >> 1][(2 * j + 1) & 3] * silu_f(rb)); }
        *(u32x4*)(OG + (size_t)t * D + 16 * F.lane) = (u32x4){w[0], w[1], w[2], w[3]}; *(u32x4*)(OG + (size_t)t * D + 16 * F.lane + 8) = (u32x4){w[4], w[5], w[6], w[7]};
    }
}

DI void swa_phase(const Frame& F, const bf16_t* QKV, const float* sinks, bf16_t* AO) {
    constexpr int KB = 0, VT = 36864;
    constexpr float L2E = 1.4426950408889634f;
    LAS unsigned char* lds = F.lds;
    const int tid = F.tid, lane = F.lane, w = F.wave, q4 = lane >> 4, r16 = lane & 15;
    const LAS unsigned char* kbase = lds + KB + (16 * w + r16) * 144 + q4 * 16;
    const LAS unsigned char* vbase = lds + VT + r16 * 528 + (16 * w + 4 * q4) * 2;
    LAS float* sinkl = (LAS float*)(lds + 70656);
    if (tid < 16) sinkl[tid] = sinks[tid];
    for (int unit = blockIdx.x; unit < 512; unit += F.G) {
        const int kh = unit & 1, n = (unit >> 1) & 15, b = unit >> 5;
        const long tokq0 = (long)b * SEQ + n * 128, tokk0 = tokq0 - 128;
        { const int row0 = tid >> 3, c8 = tid & 7;
          const bf16_t* src0 = QKV + (size_t)(tokk0 + row0) * QKV_N + 1024 + kh * 64 + c8 * 8;
          LAS unsigned char* kdst = lds + KB + row0 * 144 + c8 * 16; LAS unsigned char* vdst = lds + VT + c8 * (8 * 528) + row0 * 2;
#pragma unroll
          for (int i = 0; i < 4; ++i) {
              u32x4 kv = (u32x4){0u, 0u, 0u, 0u}, vv = (u32x4){0u, 0u, 0u, 0u};
              if ((n > 0) || (i >= 2)) { kv = *(const u32x4*)(src0 + (size_t)i * 64 * QKV_N); vv = *(const u32x4*)(src0 + (size_t)i * 64 * QKV_N + 128); }
              *(LAS u32x4*)(kdst + i * 64 * 144) = kv;
              const unsigned wv[4] = {vv.x, vv.y, vv.z, vv.w};
#pragma unroll
              for (int j = 0; j < 4; ++j) { *(LAS bf16_t*)(vdst + (2 * j) * 528 + i * 128) = (bf16_t)(wv[j] & 0xffffu); *(LAS bf16_t*)(vdst + (2 * j + 1) * 528 + i * 128) = (bf16_t)(wv[j] >> 16); } } }
        const size_t qtok = (size_t)(tokq0 + 16 * w + r16);
        const bf16_t* qrow = QKV + qtok * QKV_N + kh * 512 + q4 * 8;
        bf16x8 qn[2][2];
#pragma unroll
        for (int hh = 0; hh < 2; ++hh)
#pragma unroll
            for (int s2 = 0; s2 < 2; ++s2) qn[hh][s2] = *(const bf16x8*)(qrow + hh * 64 + 32 * s2);
        __syncthreads();
        float cm[4];
#pragma unroll
        for (int rr = 0; rr < 4; ++rr) cm[rr] = (float)(r16 - 4 * q4 - rr);
#pragma unroll 1
        for (int gp = 0; gp < 4; ++gp) {
            asm volatile("" ::: "memory");
            bf16x8 qc[2][2];
#pragma unroll
            for (int hh = 0; hh < 2; ++hh)
#pragma unroll
                for (int s2 = 0; s2 < 2; ++s2) qc[hh][s2] = qn[hh][s2];
            if (gp < 3) {
#pragma unroll
                for (int hh = 0; hh < 2; ++hh)
#pragma unroll
                    for (int s2 = 0; s2 < 2; ++s2) qn[hh][s2] = *(const bf16x8*)(qrow + (2 * gp + 2 + hh) * 64 + 32 * s2); }
            f32x4 sc[2][9];
#pragma unroll
            for (int kt = 0; kt < 9; ++kt) { sc[0][kt] = (f32x4){0.f, 0.f, 0.f, 0.f}; sc[1][kt] = (f32x4){0.f, 0.f, 0.f, 0.f};
#pragma unroll
                for (int s2 = 0; s2 < 2; ++s2) { const bf16x8 kf = *(const LAS bf16x8*)(kbase + kt * 2304 + s2 * 64);
                    sc[0][kt] = __builtin_amdgcn_mfma_f32_16x16x32_bf16(kf, qc[0][s2], sc[0][kt], 0, 0, 0); sc[1][kt] = __builtin_amdgcn_mfma_f32_16x16x32_bf16(kf, qc[1][s2], sc[1][kt], 0, 0, 0); } }
            float inv[2];
#pragma unroll
            for (int hh = 0; hh < 2; ++hh) {
                const int hq = kh * 8 + 2 * gp + hh; const float slope2 = exp2f(-0.5f * (float)(hq + 1)) * L2E, sink2 = sinkl[hq] * L2E;
                const f32x2 nb0 = (f32x2){-slope2 * cm[0], -slope2 * cm[1]}, nb1 = (f32x2){-slope2 * cm[2], -slope2 * cm[3]};
                float mx = -1e30f;
#pragma unroll
                for (int kt = 0; kt < 9; ++kt) { const bool tile_ok = (n > 0) || (w + kt >= 8); const float tkn = -slope2 * (float)(128 - 16 * kt);
                    f32x2 v0 = (f32x2){sc[hh][kt][0], sc[hh][kt][1]} * (0.125f * L2E) + (nb0 + tkn), v1 = (f32x2){sc[hh][kt][2], sc[hh][kt][3]} * (0.125f * L2E) + (nb1 + tkn);
                    float vv[4] = {v0.x, v0.y, v1.x, v1.y};
#pragma unroll
                    for (int rr = 0; rr < 4; ++rr) { bool ok = tile_ok; if (kt == 0) ok = ok && (cm[rr] < 0.f); if (kt == 8) ok = ok && (cm[rr] >= 0.f);
                        if (kt == 0 || kt == 8) vv[rr] = ok ? vv[rr] : -1e30f; else vv[rr] = tile_ok ? vv[rr] : -1e30f; sc[hh][kt][rr] = vv[rr]; }
                    mx = fmaxf(mx, fmaxf(fmaxf(vv[0], vv[1]), fmaxf(vv[2], vv[3]))); }
                mx = fmaxf(mx, __shfl_xor(mx, 16)); mx = fmaxf(mx, __shfl_xor(mx, 32)); mx = fmaxf(mx, sink2);
                f32x2 l2 = (f32x2){0.f, 0.f};
#pragma unroll
                for (int kt = 0; kt < 9; ++kt) { const f32x2 d0 = (f32x2){sc[hh][kt][0], sc[hh][kt][1]} - mx, d1 = (f32x2){sc[hh][kt][2], sc[hh][kt][3]} - mx;
                    const f32x2 p0 = (f32x2){__builtin_amdgcn_exp2f(d0.x), __builtin_amdgcn_exp2f(d0.y)}, p1 = (f32x2){__builtin_amdgcn_exp2f(d1.x), __builtin_amdgcn_exp2f(d1.y)};
                    sc[hh][kt] = (f32x4){p0.x, p0.y, p1.x, p1.y}; l2 = l2 + (p0 + p1); }
                float l = l2.x + l2.y;
                l += __shfl_xor(l, 16); l += __shfl_xor(l, 32); l += __builtin_amdgcn_exp2f(sink2 - mx);
                inv[hh] = __builtin_amdgcn_rcpf(l); }
            f32x4 o[2][4];
#pragma unroll
            for (int dt = 0; dt < 4; ++dt) { o[0][dt] = (f32x4){0.f, 0.f, 0.f, 0.f}; o[1][dt] = (f32x4){0.f, 0.f, 0.f, 0.f}; }
#pragma unroll
            for (int c = 0; c < 5; ++c) {
                bf16x8 pf[2];
#pragma unroll
                for (int hh = 0; hh < 2; ++hh) { u32x4 pw4; pw4.x = cvt_pk_bf16(sc[hh][2 * c][0], sc[hh][2 * c][1]); pw4.y = cvt_pk_bf16(sc[hh][2 * c][2], sc[hh][2 * c][3]);
                    if (c < 4) { pw4.z = cvt_pk_bf16(sc[hh][2 * c + 1][0], sc[hh][2 * c + 1][1]); pw4.w = cvt_pk_bf16(sc[hh][2 * c + 1][2], sc[hh][2 * c + 1][3]); } else { pw4.z = 0u; pw4.w = 0u; }
                    pf[hh] = __builtin_bit_cast(bf16x8, pw4); }
#pragma unroll
                for (int dt = 0; dt < 4; ++dt) { const u32x2 vlo = *(const LAS u32x2*)(vbase + dt * 8448 + (2 * c) * 32);
                    u32x2 vhi = (u32x2){0u, 0u}; if (c < 4) vhi = *(const LAS u32x2*)(vbase + dt * 8448 + (2 * c + 1) * 32);
                    const bf16x8 vf = __builtin_bit_cast(bf16x8, (u32x4){vlo.x, vlo.y, vhi.x, vhi.y});
                    o[0][dt] = __builtin_amdgcn_mfma_f32_16x16x32_bf16(vf, pf[0], o[0][dt], 0, 0, 0); o[1][dt] = __builtin_amdgcn_mfma_f32_16x16x32_bf16(vf, pf[1], o[1][dt], 0, 0, 0); } }
#pragma unroll
            for (int hh = 0; hh < 2; ++hh)
#pragma unroll
                for (int dt = 0; dt < 4; ++dt) *(u32x2*)(AO + qtok * D + (kh * 8 + 2 * gp + hh) * 64 + 16 * dt + 4 * q4) = (u32x2){cvt_pk_bf16(o[hh][dt][0] * inv[hh], o[hh][dt][1] * inv[hh]), cvt_pk_bf16(o[hh][dt][2] * inv[hh], o[hh][dt][3] * inv[hh])};
        }
        __syncthreads();
    }
}

struct MoeMeta { int* re; float* rw; int* pos; int* cnt; int* tile; };
template <bool FP8>
DI void moe_route_phase(const Frame& F, const bf16_t* X, const float* gain, const float* wr, bf16_t* XN, const MoeMeta& mm) {
    LAS float* wl = (LAS float*)F.lds;
    LAS int* cl = (LAS int*)(F.lds + 32768);
    for (int q = F.tid; q < 2048; q += NTHR) { const int k = q >> 1, h = q & 1, L = (k & 255) >> 2, i = k & 3, j = k >> 8; ((LAS f32x4*)wl)[((j * 4 + i) * 2 + h) * 64 + L] = *(const f32x4*)(wr + 4 * q); }
    f32x4 gv[4]; load_row(gain, F.lane, gv);
    for (int blk = blockIdx.x; blk < T / 128; blk += F.G) {
        if (F.tid < 8) cl[F.tid] = 0;
        __syncthreads();
        f32x4 vn[4]; load_row(X + (size_t)(blk * 128 + F.wave * 16) * D, F.lane, vn);
        for (int ti = 0; ti < 16; ++ti) { const int t = blk * 128 + F.wave * 16 + ti;
            f32x4 v[4];
#pragma unroll
            for (int j = 0; j < 4; ++j) v[j] = vn[j];
            if (ti < 15) load_row(X + (size_t)(t + 1) * D, F.lane, vn);
            const float rs = row_rstd(v);
            float lg[8];
#pragma unroll
            for (int e = 0; e < 8; ++e) lg[e] = 0.f;
#pragma unroll
            for (int j = 0; j < 4; ++j) { float hv[4];
#pragma unroll
                for (int i = 0; i < 4; ++i) hv[i] = v[j][i] * rs * gv[j][i];
                if constexpr (FP8) { *(unsigned*)((unsigned char*)XN + (size_t)t * D + 4 * F.lane + 256 * j) = cvt4_fp8(hv[0], hv[1], hv[2], hv[3]); }
                else { u32x2 w; w.x = cvt_pk_bf16(hv[0], hv[1]); w.y = cvt_pk_bf16(hv[2], hv[3]); *(u32x2*)(XN + (size_t)t * D + 4 * F.lane + 256 * j) = w; }
#pragma unroll
                for (int i = 0; i < 4; ++i) { const LAS f32x4* wp = (const LAS f32x4*)wl + ((j * 4 + i) * 2) * 64 + F.lane; const f32x4 w0 = wp[0], w1 = wp[64];
                    lg[0] += hv[i] * w0[0]; lg[1] += hv[i] * w0[1]; lg[2] += hv[i] * w0[2]; lg[3] += hv[i] * w0[3]; lg[4] += hv[i] * w1[0]; lg[5] += hv[i] * w1[1]; lg[6] += hv[i] * w1[2]; lg[7] += hv[i] * w1[3]; } }
#pragma unroll
            for (int e = 0; e < 8; ++e) lg[e] = wave_sum(lg[e]);
            int e0 = 0; float v0 = lg[0];
#pragma unroll
            for (int e = 1; e < 8; ++e) if (lg[e] > v0) { v0 = lg[e]; e0 = e; }
            int e1 = -1; float v1 = -3.0e38f;
#pragma unroll
            for (int e = 0; e < 8; ++e) if (e != e0 && lg[e] > v1) { v1 = lg[e]; e1 = e; }
            if (F.lane == 0) { const float ex = expf(v1 - v0), w0 = 1.f / (1.f + ex); mm.re[t] = e0 | (e1 << 8); mm.rw[2 * t] = w0; mm.rw[2 * t + 1] = ex * w0; __hip_atomic_fetch_add(cl + e0, 1, __ATOMIC_RELAXED, __HIP_MEMORY_SCOPE_WORKGROUP); __hip_atomic_fetch_add(cl + e1, 1, __ATOMIC_RELAXED, __HIP_MEMORY_SCOPE_WORKGROUP); }
        }
        __syncthreads();
        if (F.tid < 8) mm.cnt[blk * 8 + F.tid] = cl[F.tid];
        __syncthreads();
    }
}
template <bool FP8>
DI void moe_dispatch_phase(const Frame& F, const bf16_t* XN, bf16_t* XS, const MoeMeta& mm) {
    LAS int* pre = (LAS int*)F.lds;
    LAS int* base = (LAS int*)(F.lds + 8192);
    LAS int* posl = (LAS int*)(F.lds + 8192 + 64);
    constexpr int NB = T / 128;
    for (int i = F.tid; i < NB * 8; i += NTHR) pre[i] = __hip_atomic_load(mm.cnt + i, __ATOMIC_RELAXED, __HIP_MEMORY_SCOPE_AGENT);
    __syncthreads();
    {
      static_assert(NB == 256 && NWAVES == 8, "one wave per expert, four blocks per lane");
      const int e = F.wave; int cb[4], s = 0;
#pragma unroll
      for (int k = 0; k < 4; ++k) { cb[k] = pre[(4 * F.lane + k) * 8 + e]; s += cb[k]; }
      int inc = s;
#pragma unroll
      for (int off = 1; off < 64; off <<= 1) { const int o = __shfl_up(inc, off); if (F.lane >= off) inc += o; }
      int run = inc - s;
#pragma unroll
      for (int k = 0; k < 4; ++k) { pre[(4 * F.lane + k) * 8 + e] = run; run += cb[k]; }
      if (F.lane == 63) base[8 + e] = (inc + 255) & ~255; }
    __syncthreads();
    if (F.tid == 0) { int run = 0; for (int e = 0; e < 8; ++e) { base[e] = run; run += base[8 + e]; }
        if (blockIdx.x == 0) { int nt = 0; for (int e = 0; e < 8; ++e) { const int ntile = base[8 + e] >> 8; for (int k = 0; k < ntile; ++k) mm.tile[nt + k] = e; nt += ntile; } mm.tile[MOE_TILES] = nt; } }
    __syncthreads();
    for (int blk = blockIdx.x; blk < NB; blk += F.G) {
        if (F.wave == 0) { int run[8];
#pragma unroll
            for (int e = 0; e < 8; ++e) run[e] = base[e] + pre[blk * 8 + e];
            for (int hf = 0; hf < 2; ++hf) { const int tl = hf * 64 + F.lane, t = blk * 128 + tl; const int re = __hip_atomic_load(mm.re + t, __ATOMIC_RELAXED, __HIP_MEMORY_SCOPE_AGENT), e0 = re & 255, e1 = re >> 8; int p0 = 0, p1 = 0;
#pragma unroll
                for (int e = 0; e < 8; ++e) { const unsigned long long m = __ballot((e0 == e) || (e1 == e)); const int rank = __popcll(m & ((1ull << F.lane) - 1ull));
                    if (e0 == e) p0 = run[e] + rank; if (e1 == e) p1 = run[e] + rank; run[e] += __popcll(m); }
                posl[2 * tl] = p0; posl[2 * tl + 1] = p1; mm.pos[2 * t] = p0; mm.pos[2 * t + 1] = p1; } }
        __syncthreads();
        for (int rc = F.wave; rc < 256; rc += NWAVES) { const int tl = rc >> 1, t = blk * 128 + tl, ps = posl[rc];
            if constexpr (FP8) { *((u32x4*)((unsigned char*)XS + (size_t)ps * D) + F.lane) = *((const u32x4*)((const unsigned char*)XN + (size_t)t * D) + F.lane); }
            else { const u32x4* src = (const u32x4*)(XN + (size_t)t * D) + 2 * F.lane; u32x4* dst = (u32x4*)(XS + (size_t)ps * D) + 2 * F.lane; const u32x4 a = src[0], c = src[1]; dst[0] = a; dst[1] = c; } }
        __syncthreads();
    }
}
template <bool FINAL>
DI void moe_combine_phase(const Frame& F, bf16_t* X, const bf16_t* YS, const bf16_t* PART, const MoeMeta& mm, const float* gain, bf16_t* XN, float* OUT) {
    f32x4 gv[4]; load_row(gain, F.lane, gv);
    int nsr; { int R, nsp; pg8::sk_split(__hip_atomic_load(mm.tile + MOE_TILES, __ATOMIC_RELAXED, __HIP_MEMORY_SCOPE_AGENT), D / 256, F.G, R, nsp); nsr = nsp * 256; }
    for (int t = F.gw; t < T; t += F.ngw) {
        const int p0 = __hip_atomic_load(mm.pos + 2 * t, __ATOMIC_RELAXED, __HIP_MEMORY_SCOPE_AGENT), p1 = __hip_atomic_load(mm.pos + 2 * t + 1, __ATOMIC_RELAXED, __HIP_MEMORY_SCOPE_AGENT);
        const float w0 = __hip_atomic_load(mm.rw + 2 * t, __ATOMIC_RELAXED, __HIP_MEMORY_SCOPE_AGENT), w1 = __hip_atomic_load(mm.rw + 2 * t + 1, __ATOMIC_RELAXED, __HIP_MEMORY_SCOPE_AGENT);
        f32x4 v[4]; load_row(X + (size_t)t * D, F.lane, v);
#pragma unroll
        for (int j = 0; j < 4; ++j) { const u32x2 a = *(const u32x2*)(YS + (size_t)p0 * D + 4 * F.lane + 256 * j), c = *(const u32x2*)(YS + (size_t)p1 * D + 4 * F.lane + 256 * j);
            v[j][0] += w0 * bf_lo(a.x) + w1 * bf_lo(c.x); v[j][1] += w0 * bf_hi(a.x) + w1 * bf_hi(c.x); v[j][2] += w0 * bf_lo(a.y) + w1 * bf_lo(c.y); v[j][3] += w0 * bf_hi(a.y) + w1 * bf_hi(c.y); }
        if (p0 < nsr || p1 < nsr) {
#pragma unroll 1
            for (int s = 0; s < 2; ++s) { const int p = s ? p1 : p0; const float w = s ? w1 : w0; if (p >= nsr) continue;
#pragma unroll 1
                for (int ch = 0; ch < pg8::SK_NCH - 1; ++ch) { const bf16_t* pp = PART + (size_t)ch * SK_PART_STRIDE + (size_t)p * D + 4 * F.lane;
#pragma unroll
                    for (int j = 0; j < 4; ++j) { const u32x2 a = *(const u32x2*)(pp + 256 * j); v[j][0] += w * bf_lo(a.x); v[j][1] += w * bf_hi(a.x); v[j][2] += w * bf_lo(a.y); v[j][3] += w * bf_hi(a.y); } } }
        }
        const float rs = row_rstd(v);
#pragma unroll
        for (int j = 0; j < 4; ++j) {
            if (FINAL) { *(f32x4*)(OUT + (size_t)t * D + 4 * F.lane + 256 * j) = (f32x4){v[j][0] * rs * gv[j][0], v[j][1] * rs * gv[j][1], v[j][2] * rs * gv[j][2], v[j][3] * rs * gv[j][3]}; }
            else { *(u32x2*)(X + (size_t)t * D + 4 * F.lane + 256 * j) = (u32x2){cvt_pk_bf16(v[j][0], v[j][1]), cvt_pk_bf16(v[j][2], v[j][3])};
                u32x2 w; w.x = cvt_pk_bf16(v[j][0] * rs * gv[j][0], v[j][1] * rs * gv[j][1]); w.y = cvt_pk_bf16(v[j][2] * rs * gv[j][2], v[j][3] * rs * gv[j][3]); *(u32x2*)(XN + (size_t)t * D + 4 * F.lane + 256 * j) = w; } }
    }
}

constexpr int NPHASE = 33;
struct Args { const float* in[50]; float* out; unsigned char* ws; int ph_lo, ph_hi; };
__global__ void __launch_bounds__(NTHR, 2) trunk_fwd(Args args) {
    extern __shared__ __attribute__((aligned(16))) unsigned char lds_raw[];
    Frame F;
    F.lds = (LAS unsigned char*)lds_raw;
    F.tid = threadIdx.x; F.lane = F.tid & 63; F.wave = __builtin_amdgcn_readfirstlane(F.tid >> 6);
    F.G = gridDim.x; F.gw = blockIdx.x * NWAVES + F.wave; F.ngw = F.G * NWAVES;
    const Frame F0 = F;
    unsigned char* ws = args.ws;
    volatile LAS unsigned* MISC = (volatile LAS unsigned*)(F.lds + LDS_MISC_OFF);
    if (F.tid < 64) MISC[F.tid] = 0u;
    __syncthreads();
#if !MK_PER_PHASE
    XcdBarrier bar = xcd_barrier_post((unsigned*)(ws + WS_CTL) + CW_BAR, MISC + 8);
#define GRID_BAR() xcd_barrier(bar)
#else
#define GRID_BAR() do {} while (0)
#endif
    const int lo = args.ph_lo, hi = args.ph_hi;
#define IN(k) (lo <= (k) && (k) < hi)
#define SEAM(k) do { if (IN(k) && IN((k) + 1)) GRID_BAR(); } while (0)
    LAS unsigned char* lds = F.lds;
    const int G = F.G, c = (int)blockIdx.x;
    bf16_t* XN = (bf16_t*)(ws + WS_XN);
    unsigned char* WA = ws + WS_WA; unsigned char* ACT = ws + WS_ACT;
    bf16_t* XRES = (bf16_t*)(ACT + AC_XB);

#define S5_PARAMS(base) S5P{args.in[(base)], args.in[(base) + 1], args.in[(base) + 2], args.in[(base) + 3], args.in[(base) + 4], args.in[(base) + 5], args.in[(base) + 6], args.in[(base) + 7], args.in[(base) + 8], args.in[(base) + 9]}
#define S5_PREP(pbase, xin, ln) { const S5P sp = S5_PARAMS(pbase); \
        convert_matrix(F, sp.w_glu, D, D, D, (bf16_t*)(WA + WA_WGLU), D, RowId{}, 1, 0, 0); \
        __syncthreads(); s5_tables_phase(F, sp, (bf16_t*)(WA + WA_TG), (bf16_t*)(WA + WA_FG)); \
        norm_to_ug_phase(F, xin, ln, (bf16_t*)(ACT + AC_UG), XRES); }
#define S5_SLOC(pbase) { pg8::Gemm g{(const bf16_t*)(ACT + AC_UG), (const bf16_t*)(WA + WA_FG), S5LD, S5K, S5K}; \
        pg8::BatchOrder S{64, S5ROWS / 256, 1, G, c, 256L * S5LD * 2, 256L * S5K * 2, (long)S5ROWS * S5LD * 2, 256L * S5K * 2}; \
        pg8::EpiSloc E{(float*)(ACT + AC_SLOC)}; pg8::gemm_phase(lds, F.tid, g, S, E); \
        __syncthreads();     \
        { const S5P sp = S5_PARAMS(pbase); pg8::Unit u; for (int i = 0; S.next(i, u); ++i) s5_scan_tile(F, sp, (const float*)(ACT + AC_SLOC), (bf16_t*)(ACT + AC_UG), u.aux, u.pm); } }
#define S5_SCAN(pbase) { const S5P sp = S5_PARAMS(pbase); s5_scan_phase(F, sp, (const float*)(ACT + AC_SLOC), (bf16_t*)(ACT + AC_UG)); }
#define S5_Y(pbase) { pg8::Gemm g{(const bf16_t*)(ACT + AC_UG), (const bf16_t*)(WA + WA_TG), S5LD, S5LD, S5LD}; \
        pg8::BatchOrder S{64, S5ROWS / 256, S5K / 256, G, c, 256L * S5LD * 2, 256L * S5LD * 2, (long)S5ROWS * S5LD * 2, (long)S5K * S5LD * 2}; \
        pg8::EpiS5Y E{(bf16_t*)(ACT + AC_YMAT)}; pg8::gemm_phase(lds, F.tid, g, S, E); }
#define S5_GLU(pbase, xin, XBF) { pg8::Gemm g{(const bf16_t*)(ACT + AC_YMAT), (const bf16_t*)(WA + WA_WGLU), 16, D, D, T * 32}; \
        pg8::PlainOrder S; S.init(T, D, G, c, 16, D); pg8::EpiGlu<XBF> E{xin, XRES, (const bf16_t*)(ACT + AC_YMAT), args.in[(pbase) + 9]}; pg8::gemm_phase(lds, F.tid, g, S, E); }
#define FFN_CONVERT(wbase) do { convert_matrix(F, args.in[(wbase)], D, 2 * FFN_H, 2 * FFN_H, (bf16_t*)(WA + WA_FGU), D, RowGU{FFN_H}, 1, 0, 0); \
        convert_matrix(F, args.in[(wbase) + 1], FFN_H, D, D, (bf16_t*)(WA + WA_FDN), FFN_H, RowId{}, 1, 0, 0); } while (0)
#define FFN_CONVERT8(wbase) do { convert_matrix8(F, args.in[(wbase)], D, 2 * FFN_H, 2 * FFN_H, (unsigned char*)(WA + WA_FGU), D, RowGU{FFN_H}, 1, 0, 0); \
        convert_matrix8(F, args.in[(wbase) + 1], FFN_H, D, D, (unsigned char*)(WA + WA_FDN), FFN_H, RowId{}, 1, 0, 0); } while (0)
#define FFN_GU8() { pg8::Gemm g{XN, (const bf16_t*)(WA + WA_FGU), D / 2, D / 2, D / 2}; pg8::PlainOrder S; S.init(T, 2 * FFN_H, G, c, D / 2, D / 2); \
        pg8::EpiSwiGLU8 E{(unsigned char*)(ACT + AC_H), (size_t)T * 32}; pg8::gemm_phase<pg8::EpiSwiGLU8, pg8::PlainOrder, true>(lds, F.tid, g, S, E); }
#define FFN_DN8() { pg8::Gemm g{(const bf16_t*)(ACT + AC_H), (const bf16_t*)(WA + WA_FDN), 16, FFN_H / 2, FFN_H / 2, T * 32}; pg8::PlainOrder S; S.init(T, D, G, c, 16, FFN_H / 2);     \
        pg8::EpiResAdd E{XRES, nullptr}; pg8::gemm_phase<pg8::EpiResAdd, pg8::PlainOrder, true>(lds, F.tid, g, S, E); }
#define FFN_GU() { pg8::Gemm g{XN, (const bf16_t*)(WA + WA_FGU), D, D, D}; pg8::PlainOrderB S; S.init(T, 2 * FFN_H, G, c, D, D); \
        pg8::EpiSwiGLU E{(bf16_t*)(ACT + AC_H), FFN_H}; pg8::gemm_phase(lds, F.tid, g, S, E); }
#define FFN_DN() { pg8::Gemm g{(const bf16_t*)(ACT + AC_H), (const bf16_t*)(WA + WA_FDN), FFN_H, FFN_H, FFN_H}; pg8::PlainOrder S; S.init(T, D, G, c, FFN_H, FFN_H); \
        pg8::EpiResAdd E{XRES, nullptr}; pg8::gemm_phase(lds, F.tid, g, S, E); }
#define MOE_META(set) MoeMeta{(int*)(ws + WS_MISC + (set) * MS_SET + MS_RE), (float*)(ws + WS_MISC + (set) * MS_SET + MS_RW), (int*)(ws + WS_MISC + (set) * MS_SET + MS_POS), \
        (int*)(ws + WS_MISC + (set) * MS_SET + MS_CNT), (int*)(ws + WS_MISC + (set) * MS_SET + MS_TILE)}
#define MOE_ROUTE(set, ln, wbase) { const MoeMeta mm = MOE_META(set); \
        convert_matrix(F, args.in[(wbase) + 1], D, 2 * EXP_H, 2 * EXP_H, (bf16_t*)(WA + WA_MGU), D, RowGU{EXP_H}, NEXP, (size_t)D * 2 * EXP_H, (size_t)D * 2 * EXP_H); \
        convert_matrix(F, args.in[(wbase) + 2], EXP_H, D, D, (bf16_t*)(WA + WA_MDN), EXP_H, RowId{}, NEXP, (size_t)D * EXP_H, (size_t)D * EXP_H); \
        __syncthreads(); moe_route_phase<false>(F, XRES, ln, args.in[(wbase)], XN, mm); }
#define MOE_ROUTE8(set, ln, wbase) { const MoeMeta mm = MOE_META(set); \
        convert_matrix8(F, args.in[(wbase) + 1], D, 2 * EXP_H, 2 * EXP_H, (unsigned char*)(WA + WA_MGU), D, RowGU{EXP_H}, NEXP, (size_t)D * 2 * EXP_H, (size_t)D * 2 * EXP_H); \
        convert_matrix8(F, args.in[(wbase) + 2], EXP_H, D, D, (unsigned char*)(WA + WA_MDN), EXP_H, RowId{}, NEXP, (size_t)D * EXP_H, (size_t)D * EXP_H); \
        __syncthreads(); moe_route_phase<true>(F, XRES, ln, args.in[(wbase)], XN, mm); }
#define MOE_DISPATCH(set) { const MoeMeta mm = MOE_META(set); moe_dispatch_phase<false>(F, XN, (bf16_t*)(ACT + AC_XS), mm); }
#define MOE_DISPATCH8(set) { const MoeMeta mm = MOE_META(set); moe_dispatch_phase<true>(F, XN, (bf16_t*)(ACT + AC_XS), mm); }
#define MOE_LOAD_TILES(set) const MoeMeta mm = MOE_META(set); LAS int* tl = (LAS int*)(lds + LDS_MISC_OFF + 256); \
        for (int i = F.tid; i <= MOE_TILES; i += NTHR) tl[i] = __hip_atomic_load(mm.tile + i, __ATOMIC_RELAXED, __HIP_MEMORY_SCOPE_AGENT); __syncthreads(); \
        const int ntile = tl[MOE_TILES];
#define MOE_GU(set) { MOE_LOAD_TILES(set) pg8::Gemm g{(const bf16_t*)(ACT + AC_XS), (const bf16_t*)(WA + WA_MGU), D, D, D}; \
        pg8::MoeOrder S{ntile, 2 * EXP_H / 256, G, c, 256L * D * 2, 256L * D * 2, (long)2 * EXP_H * D * 2, tl, 0}; \
        pg8::EpiSwiGLU E{(bf16_t*)(ACT + AC_HID), EXP_H}; pg8::gemm_phase(lds, F.tid, g, S, E); }
#define MOE_DN(set) { MOE_LOAD_TILES(set) pg8::Gemm g{(const bf16_t*)(ACT + AC_HID), (const bf16_t*)(WA + WA_MDN), EXP_H, EXP_H, EXP_H}; \
        pg8::MoeOrder S{ntile, D / 256, G, c, 256L * EXP_H * 2, 256L * EXP_H * 2, (long)D * EXP_H * 2, tl, 1}; \
        pg8::EpiStoreBf16 E{(bf16_t*)(ACT + AC_XS), D, nullptr}; pg8::gemm_phase(lds, F.tid, g, S, E); }
#define MOE_GU8(set) { MOE_LOAD_TILES(set) pg8::Gemm g{(const bf16_t*)(ACT + AC_XS), (const bf16_t*)(WA + WA_MGU), D / 2, D / 2, D / 2}; \
        pg8::MoeOrder S{ntile, 2 * EXP_H / 256, G, c, 256L * D, 256L * D, (long)2 * EXP_H * D, tl, 0}; \
        pg8::EpiSwiGLU8 E{(unsigned char*)(ACT + AC_HID), HID_GS}; pg8::gemm_phase<pg8::EpiSwiGLU8, pg8::MoeOrder, true>(lds, F.tid, g, S, E); }
#define MOE_DN8(set) { MOE_LOAD_TILES(set) pg8::Gemm g{(const bf16_t*)(ACT + AC_HID), (const bf16_t*)(WA + WA_MDN), 16, EXP_H / 2, EXP_H / 2, (int)HID_GS};     \
        pg8::MoeOrderSK S{ntile, D / 256, G, c, 256L * 32, 256L * EXP_H, (long)D * EXP_H, tl, (long)((AC_PART - AC_XS) / 2), (long)SK_PART_STRIDE, 4L * (long)HID_GS, 0, 0}; S.init(); \
        pg8::EpiStoreBf16 E{(bf16_t*)(ACT + AC_XS), D, nullptr}; pg8::gemm_phase<pg8::EpiStoreBf16, pg8::MoeOrderSK, true>(lds, F.tid, g, S, E); }

#define PH_REPS(k) (1 + PROBE_N * (int)(((unsigned long long)(PROBE_MASK) >> (k)) & 1ull))
#define PH(k, ...) do { for (int _r = 0; _r < PH_REPS(k); ++_r) { if (IN(k)) { Frame F = F0; { int _t = threadIdx.x; asm volatile("" : "+v"(_t)); F.tid = _t; F.lane = _t & 63; F.wave = __builtin_amdgcn_readfirstlane(_t >> 6); F.gw = blockIdx.x * NWAVES + F.wave; } \
        __VA_ARGS__ } if (_r + 1 < PH_REPS(k)) GRID_BAR(); } SEAM(k); } while (0)
    PH(0, S5_PREP(2, args.in[0], args.in[1]) if (FFN0_FP8) { FFN_CONVERT8(13); } else { FFN_CONVERT(13); });
    PH(1, S5_SLOC(2));
    PH(2, S5_Y(2));
    PH(3, S5_GLU(2, XRES, true));
    PH(4, norm_phase<FFN0_FP8 != 0>(F, XRES, args.in[12], XN););
    PH(5, if (FFN0_FP8) FFN_GU8() else FFN_GU());
    PH(6, if (FFN0_FP8) FFN_DN8() else FFN_DN());
    PH(7, convert_matrix(F, args.in[16], D, 3072, 3088, (bf16_t*)(WA + WA_WIN), D, RowId{}, 1, 0, 0);
          for (int id = blockIdx.x * NTHR + F.tid; id < 16 * D; id += G * NTHR) { const int j = id >> 10, k = id & 1023; ((bf16_t*)(WA + WA_WIN))[(size_t)(3072 + j) * D + k] = f2bf(args.in[16][(size_t)k * 3088 + 3072 + j]); }
          convert_matrix(F, args.in[20], D, D, D, (bf16_t*)(WA + WA_WOUT), D, RowId{}, 1, 0, 0);
          norm_phase(F, XRES, args.in[15], XN););
    PH(8, { pg8::Gemm g{XN, (const bf16_t*)(WA + WA_WIN), D, D, D}; pg8::PlainOrderB S; S.init(T, GLA_N, G, c, D, D); pg8::EpiStoreBf16 E{(bf16_t*)(ACT + AC_PROJ), GLA_N, nullptr}; pg8::gemm_phase(lds, F.tid, g, S, E); });
    PH(9, gla_prep_phase(F, (const bf16_t*)(ACT + AC_PROJ), args.in[17], args.in[18], (bf16_t*)(ACT + AC_QSB), (bf16_t*)(ACT + AC_KE), (bf16_t*)(ACT + AC_SCB), (float*)(ACT + AC_DEC)););
    PH(10, gla_seq_phase(F, (const bf16_t*)(ACT + AC_QSB), (const bf16_t*)(ACT + AC_KE), (const bf16_t*)(ACT + AC_SCB), (const bf16_t*)(ACT + AC_PROJ), (const float*)(ACT + AC_DEC), (bf16_t*)(ACT + AC_GO)););
    PH(11, gla_finalize_phase(F, (const bf16_t*)(ACT + AC_GO), (const bf16_t*)(ACT + AC_PROJ), args.in[19], XN););
    PH(12, { pg8::Gemm g{XN, (const bf16_t*)(WA + WA_WOUT), D, D, D}; pg8::PlainOrder S; S.init(T, D, G, c, D, D); pg8::EpiResAdd E{XRES, nullptr}; pg8::gemm_phase(lds, F.tid, g, S, E); });
    PH(13, MOE_ROUTE8(0, args.in[21], 22));
    PH(14, MOE_DISPATCH8(0));
    PH(15, MOE_GU8(0));
    PH(16, MOE_DN8(0));
    PH(17, { const MoeMeta mm = MOE_META(0);
          convert_matrix(F, args.in[26], D, QKV_N, QKV_N, (bf16_t*)(WA + WA_QKV), D, RowId{}, 1, 0, 0);
          convert_matrix(F, args.in[29], D, D, D, (bf16_t*)(WA + WA_SWO), D, RowId{}, 1, 0, 0);
          if (FFN2_FP8) { FFN_CONVERT8(32); } else { FFN_CONVERT(32); }
          moe_combine_phase<false>(F, XRES, (const bf16_t*)(ACT + AC_XS), (const bf16_t*)(ACT + AC_PART), mm, args.in[25], XN, nullptr); });
    PH(18, { pg8::Gemm g{XN, (const bf16_t*)(WA + WA_QKV), D, D, D}; pg8::PlainOrder S; S.init(T, 1024, G, c, D, D); pg8::EpiStoreBf16 E{(bf16_t*)(ACT + AC_QKV), QKV_N, args.in[27]}; pg8::gemm_phase(lds, F.tid, g, S, E);
        pg8::HalfOrder SH{T / 256, 4, G, c, 256L * D * 2, 256L * D * 2}; pg8::EpiStoreBf16H EH{(bf16_t*)(ACT + AC_QKV), QKV_N, args.in[27]};
        pg8::gemm_phase<pg8::EpiStoreBf16H, pg8::HalfOrder, false, true>(lds, F.tid, g, SH, EH); });
    PH(19, swa_phase(F, (const bf16_t*)(ACT + AC_QKV), args.in[28], (bf16_t*)(ACT + AC_AO)););
    PH(20, { pg8::Gemm g{(const bf16_t*)(ACT + AC_AO), (const bf16_t*)(WA + WA_SWO), D, D, D}; pg8::PlainOrder S; S.init(T, D, G, c, D, D); pg8::EpiResAdd E{XRES, args.in[30]}; pg8::gemm_phase(lds, F.tid, g, S, E); });
    PH(21, norm_phase<FFN2_FP8 != 0>(F, XRES, args.in[31], XN););
    PH(22, if (FFN2_FP8) FFN_GU8() else FFN_GU());
    PH(23, if (FFN2_FP8) FFN_DN8() else FFN_DN());
    PH(24, S5_PREP(35, XRES, args.in[34]));
    PH(25, S5_SLOC(35));
    PH(26, S5_Y(35));
    PH(27, S5_GLU(35, XRES, true));
    PH(28, MOE_ROUTE8(1, args.in[45], 46));
    PH(29, MOE_DISPATCH8(1));
    PH(30, MOE_GU8(1));
    PH(31, MOE_DN8(1));
    PH(32, { const MoeMeta mm = MOE_META(1); moe_combine_phase<true>(F, XRES, (const bf16_t*)(ACT + AC_XS), (const bf16_t*)(ACT + AC_PART), mm, args.in[49], nullptr, args.out); });
}

extern "C" void kernel_launch(void* const* d_in, const int* in_sizes, int n_in, void* d_out, int out_size, void* d_ws, size_t ws_size, hipStream_t stream) {
    static int grid = 0;
    if (grid == 0) {
        if (n_in != 50 || in_sizes[0] != T * D || out_size != T * D || ws_size < WS_END) { fprintf(stderr, "kernel_launch: unexpected problem (n_in %d, in0 %d, out %d, ws %zu < %zu)\n", n_in, n_in > 0 ? in_sizes[0] : -1, out_size, ws_size, (size_t)WS_END); grid = -1; return; }
        int dev = 0, cus = 0, per_cu = 0;
        if (hipGetDevice(&dev) != hipSuccess || hipDeviceGetAttribute(&cus, hipDeviceAttributeMultiprocessorCount, dev) != hipSuccess) { grid = -1; return; }
        if (hipFuncSetAttribute((const void*)trunk_fwd, hipFuncAttributeMaxDynamicSharedMemorySize, LDS_BYTES) != hipSuccess) { fprintf(stderr, "kernel_launch: hipFuncSetAttribute failed\n"); grid = -1; return; }
        if (hipOccupancyMaxActiveBlocksPerMultiprocessor(&per_cu, (const void*)trunk_fwd, NTHR, LDS_BYTES) != hipSuccess || per_cu < 1) fprintf(stderr, "kernel_launch: occupancy query reports %d\n", per_cu);
        (void)hipGetLastError();
        grid = cus;
    }
    if (grid < 0) return;
    (void)hipMemsetAsync((char*)d_ws + WS_CTL, 0, CTL_ZERO_BYTES, stream);
    Args a{};
    for (int i = 0; i < 50; ++i) a.in[i] = (const float*)d_in[i];
    a.out = (float*)d_out; a.ws = (unsigned char*)d_ws;
#if MK_PER_PHASE
    for (int p = 0; p < NPHASE; ++p) { a.ph_lo = p; a.ph_hi = p + 1; hipLaunchKernelGGL(trunk_fwd, dim3(grid), dim3(NTHR), LDS_BYTES, stream, a); }
#else
    a.ph_lo = 0; a.ph_hi = NPHASE; hipLaunchKernelGGL(trunk_fwd, dim3(grid), dim3(NTHR), LDS_BYTES, stream, a);
#endif
}
```

```cpp
#include <hip/hip_runtime.h>
#include <cstdio>
#include <cstdint>

#ifndef PROBE_MASK
#define PROBE_MASK 0ull
#define PROBE_N 2
#endif
#ifndef FFN2_FP8
#define FFN2_FP8 1
#endif
#ifndef FFN0_FP8
#define FFN0_FP8 0
#endif
#ifndef MK_PER_PHASE
#define MK_PER_PHASE 0
#endif

#define DI __device__ __forceinline__
#define LAS __attribute__((address_space(3)))
typedef unsigned short bf16_t;
typedef short bf16x8 __attribute__((ext_vector_type(8)));
typedef short s16x4 __attribute__((ext_vector_type(4)));
typedef float f32x4 __attribute__((ext_vector_type(4)));
typedef float f32x2 __attribute__((ext_vector_type(2)));
typedef unsigned u32x4 __attribute__((ext_vector_type(4)));
typedef unsigned u32x2 __attribute__((ext_vector_type(2)));

constexpr int T = 32768, D = 1024, SEQ = 2048, BATCH = 16;
constexpr int NWAVES = 8, NTHR = 512;
constexpr float EPS = 1e-6f;
constexpr int FFN_H = 2816, EXP_H = 3584, NEXP = 8;
constexpr int S5C = 32;
constexpr int S5ROWS = BATCH * (SEQ / S5C);
constexpr int S5K = S5C * 16;
constexpr int S5LD = S5K + 128;
constexpr int GLA_N = 3328;
constexpr int QKV_N = 1280;
constexpr int MOE_ROWS = 67584;
constexpr int MOE_TILES = 264;

constexpr size_t MiB = 1u << 20;
constexpr size_t WS_CTL = 0, CTL_ZERO_BYTES = 64 * 1024;
constexpr size_t WS_MISC = 1 * MiB;
constexpr size_t WS_WA = 4 * MiB;
constexpr size_t WS_XN = 174 * MiB;
constexpr size_t WS_ACT = 238 * MiB;
constexpr size_t WS_END = WS_ACT + 596 * MiB;
constexpr size_t WA_WGLU = 0, WA_TG = 2 * MiB, WA_FG = 42 * MiB, WA_FGU = 58 * MiB, WA_FDN = 69 * MiB;
constexpr size_t WA_WIN = 0, WA_WOUT = 7 * MiB;
constexpr size_t WA_MGU = 0, WA_MDN = 112 * MiB;
constexpr size_t WA_QKV = 0, WA_SWO = 3 * MiB;
constexpr size_t AC_UG = 0, AC_SLOC = 80 * MiB, AC_YMAT = 112 * MiB;
constexpr size_t AC_H = 0;
constexpr size_t AC_PROJ = 0, AC_GO = 208 * MiB, AC_KE = 272 * MiB, AC_SCB = 304 * MiB, AC_VTG = 320 * MiB, AC_DEC = 384 * MiB, AC_QSB = 386 * MiB;
constexpr size_t AC_XS = 0, AC_HID = 132 * MiB, AC_PART = 496 * MiB;
constexpr size_t HID_GS = (size_t)MOE_TILES * 256 * 32;
constexpr size_t SK_PART_STRIDE = (size_t)2048 * D;
constexpr size_t AC_QKV = 0, AC_AO = 80 * MiB;
constexpr size_t AC_XB = 424 * MiB;
constexpr size_t MS_SET = 1 * MiB;
constexpr size_t MS_RE = 0, MS_RW = 128 * 1024, MS_POS = 384 * 1024, MS_CNT = 640 * 1024, MS_TILE = 656 * 1024;
constexpr int CW_BAR = 1024;

constexpr int STAGE_BYTES = 131072;
constexpr int LDS_BYTES = 147456;
constexpr int LDS_MISC_OFF = LDS_BYTES - 2048;

typedef __bf16 bf16x2_t __attribute__((ext_vector_type(2)));
DI unsigned cvt_pk_bf16(float lo, float hi) { const bf16x2_t v = __builtin_convertvector((f32x2){lo, hi}, bf16x2_t); return __builtin_bit_cast(unsigned, v); }
typedef int i32x8 __attribute__((ext_vector_type(8)));
typedef int i32x4 __attribute__((ext_vector_type(4)));
DI unsigned cvt4_fp8(float a, float b, float c, float d) { int r = 0; r = __builtin_amdgcn_cvt_pk_fp8_f32(a, b, r, false); r = __builtin_amdgcn_cvt_pk_fp8_f32(c, d, r, true); return (unsigned)r; }
constexpr float W8_SCALE = 64.f;
DI float bf_lo(unsigned w) { return __uint_as_float(w << 16); }
DI float bf_hi(unsigned w) { return __uint_as_float(w & 0xffff0000u); }
DI float bf2f(bf16_t v) { return __uint_as_float(((unsigned)v) << 16); }
DI bf16_t f2bf(float f) { return (bf16_t)(cvt_pk_bf16(f, 0.f) & 0xffffu); }
DI float wave_sum(float v) {
#pragma unroll
    for (int o = 1; o < 64; o <<= 1) v += __shfl_xor(v, o);
    return v;
}
DI float sigmoid_f(float z) { return __builtin_amdgcn_rcpf(1.f + __builtin_amdgcn_exp2f(z * -1.4426950408889634f)); }
DI float silu_f(float z) { return z * sigmoid_f(z); }
DI f32x2 swiglu2(f32x2 g, f32x2 u) { const f32x2 t = g * -1.4426950408889634f; f32x2 e; e.x = __builtin_amdgcn_exp2f(t.x); e.y = __builtin_amdgcn_exp2f(t.y);
    const f32x2 d = e + 1.0f; f32x2 r; r.x = __builtin_amdgcn_rcpf(d.x); r.y = __builtin_amdgcn_rcpf(d.y); return (g * r) * u; }
DI f32x2 sigmoid2(f32x2 z) { const f32x2 t = z * -1.4426950408889634f; f32x2 e; e.x = __builtin_amdgcn_exp2f(t.x); e.y = __builtin_amdgcn_exp2f(t.y); const f32x2 d = e + 1.0f; f32x2 r; r.x = __builtin_amdgcn_rcpf(d.x); r.y = __builtin_amdgcn_rcpf(d.y); return r; }
DI f32x2 gelu_tanh2(f32x2 x) { const f32x2 u = (x * x * 0.044715f + 1.0f) * x * 1.5957691216f; return x * sigmoid2(u); }
DI float gelu_tanh_f(float x) { const float u = 1.5957691216f * (x + 0.044715f * x * x * x); return x * sigmoid_f(u); }
#define LDS_WAIT() asm volatile("s_waitcnt lgkmcnt(0)" ::: "memory")
#define LDS_BARRIER() do { asm volatile("s_waitcnt lgkmcnt(0)" ::: "memory"); __builtin_amdgcn_s_barrier(); asm volatile("" ::: "memory"); } while (0)

namespace pg8 {
constexpr int BM = 256, BK = 64, HALF = 128, HTB = HALF * BK * 2, NXCD = 8, WGM = 8;
__host__ __device__ __forceinline__ int lds_byte(int r, int c) { const int st = (r >> 4) * 2 + (c >> 5), rr = r & 15, cc = c & 31, ob = rr * 64 + cc * 2; return st * 1024 + (ob ^ (((ob >> 9) & 1) << 5)); }
__host__ __device__ __forceinline__ void stage_rc(int b, int& R, int& C) { const int st = b / 1024, sb = b % 1024, swz = sb ^ (((sb >> 9) & 1) << 5); R = (st >> 1) * 16 + swz / 64; C = (st & 1) * 32 + (swz % 64) / 2; }
__host__ __device__ __forceinline__ int perm32(int rho) { const int n = rho >> 4, i = rho & 15; return 8 * (i >> 2) + 4 * n + (i & 3); }

struct Unit { int pm, pn, aux; long aoff, boff; int kt = 0; long ooff = 0; };
struct Gemm { const bf16_t* A; const bf16_t* Bt; int lda, ldb, K; int a_cs16 = 32; };

DI bool tile_of(long L, int nM, int nN, int& pm, int& pn) {
    const int nwg = nM * nN; if (L >= nwg) return false;
    int wgid = (int)L; { const int q = nwg / NXCD, r = nwg % NXCD, xcd = wgid % NXCD, off = wgid / NXCD; wgid = (xcd < r ? xcd * (q + 1) : r * (q + 1) + (xcd - r) * q) + off; }
    const int nig = WGM * nN, gid = wgid / nig, fm = gid * WGM, gsz = (nM - fm) < WGM ? (nM - fm) : WGM;
    pm = fm + ((wgid % nig) % gsz); pn = (wgid % nig) / gsz; return true;
}
DI bool tile_of_bhot(long L, int nM, int nN, int& pm, int& pn) {
    const int nwg = nM * nN; if (L >= nwg) return false;
    int wgid = (int)L; { const int q = nwg / NXCD, r = nwg % NXCD, xcd = wgid % NXCD, off = wgid / NXCD; wgid = (xcd < r ? xcd * (q + 1) : r * (q + 1) + (xcd - r) * q) + off; }
    const int full = nN >> 2, idsFull = full * 4 * nM; int cg, r, cw;
    if (wgid < idsFull) { cg = wgid / (4 * nM); r = wgid % (4 * nM); cw = 4; } else { cg = full; r = wgid - idsFull; cw = nN & 3; }
    const int rb = r / (8 * cw), q = r % (8 * cw);
    pm = rb * 8 + (q & 7); pn = 4 * cg + (q >> 3); return true;
}
struct PlainOrder {
    int nM, nN, G, c; long atile, btile;
    DI void init(int M, int N, int G_, int c_, int lda, int ldb) { nM = M / BM; nN = N / BM; G = G_; c = c_; atile = (long)BM * lda * 2; btile = (long)BM * ldb * 2; }
    DI bool next(int i, Unit& u) const { int pm, pn; if (!tile_of((long)i * G + c, nM, nN, pm, pn)) return false; u.pm = pm; u.pn = pn; u.aux = 0; u.aoff = pm * atile; u.boff = pn * btile; return true; }
};
struct PlainOrderB : PlainOrder {
    DI bool next(int i, Unit& u) const { int pm, pn; if (!tile_of_bhot((long)i * G + c, nM, nN, pm, pn)) return false; u.pm = pm; u.pn = pn; u.aux = 0; u.aoff = pm * atile; u.boff = pn * btile; return true; }
};
struct BatchOrder {
    int ng, nM, nN, G, c; long atile, btile, astride, bstride;
    DI bool next(int i, Unit& u) const {
        const long L0 = (long)i * G + c; const int per = nM * nN, nwg = ng * per; if (L0 >= (long)nwg) return false;
        int L = (int)L0; { const int q = nwg / NXCD, r = nwg % NXCD, xcd = L % NXCD, off = L / NXCD; L = (xcd < r ? xcd * (q + 1) : r * (q + 1) + (xcd - r) * q) + off; }
        const int g = (int)(L / per), r = (int)(L % per); u.pm = r % nM; u.pn = r / nM; u.aux = g;
        u.aoff = g * astride + u.pm * atile; u.boff = g * bstride + u.pn * btile; return true; }
};
struct HalfOrder {
    int nM, pn, G, c; long atile, btile;
    DI bool next(int i, Unit& u) const { const int L = i * G + c; if (L >= 2 * nM) return false; const int xcd = L & 7, off = L >> 3, pm = xcd * (nM >> 3) + (off >> 1), h = off & 1;
        u.pm = pm; u.pn = pn; u.aux = 0; u.kt = 0; u.ooff = 128 * h; u.aoff = pm * atile; u.boff = pn * btile + h * (btile >> 1); return true; }
};
struct MoeOrder {
    int nM, nN, G, c; long atile, btile, bstride; const LAS int* tile_e; int rev;
    DI bool next(int i, Unit& u) const { int pm, pn; if (!tile_of((long)i * G + c, nM, nN, pm, pn)) return false; if (rev) pm = nM - 1 - pm; const int e = tile_e[pm];
        u.pm = pm; u.pn = pn; u.aux = e; u.aoff = pm * atile; u.boff = e * bstride + pn * btile; return true; }
};
constexpr int SK_NCH = 7, SK_CKT = 4;
DI void sk_split(int nM, int nN, int G, int& R, int& nsp) { const int nu = nM * nN; if (G % nN) { R = (nu + G - 1) / G; nsp = 0; return; } R = nu / G; nsp = (nu - R * G) / nN; }
struct MoeOrderSK {
    int nM, nN, G, c; long atile, btile, bstride; const LAS int* tile_e; long part_off, part_stride, akt; int R, nsp;
    DI void init() { sk_split(nM, nN, G, R, nsp); }
    DI bool next(int i, Unit& u) const {
        if (i < R) { int pm, pn; if (!tile_of((long)i * G + c, nM - nsp, nN, pm, pn)) return false; pm = nM - 1 - pm; const int e = tile_e[pm];
            u.pm = pm; u.pn = pn; u.aux = e; u.kt = 0; u.ooff = 0; u.aoff = pm * atile; u.boff = e * bstride + pn * btile; return true; }
        const int j = (i - R) * G + c; if (j >= nsp * nN * SK_NCH) return false;
        const int ch = j % SK_NCH, q = j / SK_NCH, pn = q % nN, pm = q / nN, e = tile_e[pm]; const long ko = (long)ch * SK_CKT * 128;
        u.pm = pm; u.pn = pn; u.aux = e; u.kt = SK_CKT; u.ooff = ch ? part_off + (ch - 1) * part_stride : 0; u.aoff = pm * atile + (long)ch * SK_CKT * akt; u.boff = e * bstride + pn * btile + ko; return true; }
};

template <class Epi, class Sched, bool FP8 = false, bool NHALF = false>
DI void gemm_phase(LAS unsigned char* lds, const int tid, const Gemm g, const Sched& S, const Epi& E) {
    const int wid = __builtin_amdgcn_readfirstlane(tid >> 6), lane = tid & 63, wr = wid >> 2, wc = wid & 3, fr = lane & 15, fq = lane >> 4;
    const int K = g.K, nt = K / BK;
    unsigned voffA[2], voffB[2];
#pragma unroll
    for (int i = 0; i < 2; ++i) { int R, C; stage_rc(tid * 16 + i * 8192, R, C); const int Rb = Epi::PERM ? ((R & ~31) + perm32(R & 31)) : R;
        voffA[i] = (unsigned)(R * g.lda) * 2u + (unsigned)(C >> 4) * (unsigned)g.a_cs16 + (unsigned)(C & 15) * 2u; voffB[i] = (unsigned)(Rb * g.ldb + C) * 2u; }
    const size_t kstep = (size_t)(BK * 2), kstepA = (size_t)4 * (size_t)g.a_cs16;
    const size_t hsA = (size_t)HALF * g.lda * 2, hsB = NHALF ? (size_t)0 : (size_t)HALF * g.ldb * 2;
    const unsigned ldsw = (unsigned)wid * 1024u;
    const int aoff = lds_byte(wr * 64 + fr, fq * 8), boff = lds_byte(wc * 32 + fr, fq * 8);
#define PG8_SA(b, h) (((b) * 2 + (h)) * HTB)
#define PG8_SB(b, h) ((4 + (b) * 2 + (h)) * HTB)
#define PG8_STAGE(bufoff, gbase, voff) do { _Pragma("unroll") for (int _i = 0; _i < 2; ++_i) \
        __builtin_amdgcn_global_load_lds((const unsigned*)((const char*)(gbase) + (voff)[_i]), (LAS unsigned*)(lds + (bufoff) + ldsw + _i * 8192), 16, 0, 0); } while (0)
#define PG8_LDA(dst, b, h) do { _Pragma("unroll") for (int m = 0; m < 4; ++m) _Pragma("unroll") for (int k = 0; k < 2; ++k) dst[m][k] = *(const LAS bf16x8*)(lds + PG8_SA(b, h) + aoff + m * 2048 + k * 1024); } while (0)
#define PG8_LDB(dst, b, h) do { _Pragma("unroll") for (int n = 0; n < 2; ++n) _Pragma("unroll") for (int k = 0; k < 2; ++k) dst[n][k] = *(const LAS bf16x8*)(lds + PG8_SB(b, h) + boff + n * 2048 + k * 1024); } while (0)
#define PG8_MMA(ai, bj, At, Bt) do { if constexpr (FP8) __builtin_amdgcn_sched_barrier(0); __builtin_amdgcn_s_setprio(1); _Pragma("unroll") for (int m = 0; m < 4; ++m) _Pragma("unroll") for (int n = 0; n < 2; ++n) { \
        if constexpr (FP8) { const i32x8 b8 = __builtin_shufflevector(__builtin_bit_cast(i32x4, Bt[n][0]), __builtin_bit_cast(i32x4, Bt[n][1]), 0, 1, 2, 3, 4, 5, 6, 7), a8 = __builtin_shufflevector(__builtin_bit_cast(i32x4, At[m][0]), __builtin_bit_cast(i32x4, At[m][1]), 0, 1, 2, 3, 4, 5, 6, 7); \
            asm("v_mfma_scale_f32_16x16x128_f8f6f4 %0, %1, %2, %0, %3, %4 op_sel_hi:[0,0,0]" : "+v"(acc[ai][bj][m][n]) : "v"(b8), "v"(a8), "v"(sc_b), "v"(sc_a)); } \
        else { _Pragma("unroll") for (int k = 0; k < 2; ++k) acc[ai][bj][m][n] = __builtin_amdgcn_mfma_f32_16x16x32_bf16(Bt[n][k], At[m][k], acc[ai][bj][m][n], 0, 0, 0); } } __builtin_amdgcn_s_setprio(0); if constexpr (FP8) __builtin_amdgcn_sched_barrier(0); } while (0)
#define PG8_MMA1(ai) do { if constexpr (!NHALF) PG8_MMA(ai, 1, At, B1); } while (0)
#define PG8_WAIT_V(n) asm volatile("s_waitcnt vmcnt(" #n ")" ::: "memory")
#define PG8_WAIT_L(n) asm volatile("s_waitcnt lgkmcnt(" #n ")" ::: "memory")
#define PG8_BAR __builtin_amdgcn_s_barrier()
#define PG8_SCHED __builtin_amdgcn_sched_barrier(0)
    Unit cur, nxt; int ui = 0;
    if (!S.next(0, cur)) return;
    const int sc_b = 121, sc_a = 127;
    f32x4 acc[2][2][4][2];
#pragma unroll
    for (int a = 0; a < 2; ++a)
#pragma unroll
        for (int b = 0; b < 2; ++b)
#pragma unroll
            for (int m = 0; m < 4; ++m)
#pragma unroll
                for (int n = 0; n < 2; ++n) acc[a][b][m][n] = (f32x4){0.f, 0.f, 0.f, 0.f};
    bf16x8 At[4][2], B0[2][2], B1[2][2];
    const char* cA = (const char*)g.A + cur.aoff; const char* cB = (const char*)g.Bt + cur.boff;
    PG8_STAGE(PG8_SB(0, 0), cB, voffB); PG8_STAGE(PG8_SB(0, 1), cB + hsB, voffB); PG8_STAGE(PG8_SA(0, 0), cA, voffA); PG8_STAGE(PG8_SA(0, 1), cA + hsA, voffA);
    if (wr == 1) PG8_BAR;
    PG8_WAIT_V(2); PG8_BAR;
    PG8_STAGE(PG8_SB(1, 0), cB + kstep, voffB); PG8_STAGE(PG8_SA(1, 0), cA + kstepA, voffA); PG8_STAGE(PG8_SB(1, 1), cB + hsB + kstep, voffB);
    PG8_WAIT_V(6); PG8_BAR;
    for (;;) {
        const bool has_next = S.next(ui + 1, nxt);
        const char* nA = has_next ? (const char*)g.A + nxt.aoff : cA; const char* nB = has_next ? (const char*)g.Bt + nxt.boff : cB;
        const int ntu = cur.kt ? cur.kt : nt;
        for (int t = 0; t < ntu; t += 2) {
            const bool last = (t == ntu - 2);
            const char* a1 = cA + (size_t)(t + 1) * kstepA;
            const char* a2 = last ? nA : cA + (size_t)(t + 2) * kstepA; const char* b2 = last ? nB : cB + (size_t)(t + 2) * kstep;
            const char* a3 = a2 + kstepA; const char* b3 = b2 + kstep;
            PG8_LDB(B0, 0, 0); PG8_LDB(B1, 0, 1); PG8_SCHED; PG8_LDA(At, 0, 0); PG8_STAGE(PG8_SA(1, 1), a1 + hsA, voffA);
            PG8_WAIT_V(8); PG8_WAIT_L(0); PG8_BAR; PG8_MMA(0, 0, At, B0); PG8_MMA1(0); PG8_BAR; PG8_SCHED;
            PG8_LDA(At, 0, 1); PG8_STAGE(PG8_SB(0, 0), b2, voffB); PG8_STAGE(PG8_SB(0, 1), b2 + hsB, voffB); PG8_STAGE(PG8_SA(0, 0), a2, voffA);
            PG8_WAIT_V(8); PG8_WAIT_L(0); PG8_BAR; PG8_MMA(1, 0, At, B0); PG8_MMA1(1); PG8_BAR; PG8_SCHED;
            PG8_LDB(B0, 1, 0); PG8_LDB(B1, 1, 1); PG8_SCHED; PG8_LDA(At, 1, 0); PG8_STAGE(PG8_SA(0, 1), a2 + hsA, voffA);
            PG8_WAIT_V(8); PG8_WAIT_L(0); PG8_BAR; PG8_MMA(0, 0, At, B0); PG8_MMA1(0); PG8_BAR; PG8_SCHED;
            PG8_LDA(At, 1, 1); PG8_STAGE(PG8_SB(1, 0), b3, voffB); PG8_STAGE(PG8_SB(1, 1), b3 + hsB, voffB); PG8_STAGE(PG8_SA(1, 0), a3, voffA);
            PG8_WAIT_V(8); PG8_WAIT_L(0); PG8_BAR; PG8_MMA(1, 0, At, B0); PG8_MMA1(1); PG8_BAR; PG8_SCHED;
        }
        if (wr == 0) PG8_BAR;
        if constexpr (FP8) asm volatile("s_nop 15\n\ts_nop 15" ::: "memory");
        { int t2 = tid; asm volatile("" : "+v"(t2)); const int l2 = t2 & 63; E(acc, cur, wr, wc, l2 & 15, l2 >> 4); }
        if (!has_next) break;
#pragma unroll
        for (int a = 0; a < 2; ++a)
#pragma unroll
            for (int b = 0; b < 2; ++b)
#pragma unroll
                for (int m = 0; m < 4; ++m)
#pragma unroll
                    for (int n = 0; n < 2; ++n) acc[a][b][m][n] = (f32x4){0.f, 0.f, 0.f, 0.f};
        cur = nxt; cA = nA; cB = nB; ++ui;
        if (wr == 1) PG8_BAR;
    }
    PG8_WAIT_V(0);
    PG8_BAR;
#undef PG8_SA
#undef PG8_SB
#undef PG8_STAGE
#undef PG8_LDA
#undef PG8_LDB
#undef PG8_MMA
#undef PG8_MMA1
#undef PG8_WAIT_V
#undef PG8_WAIT_L
#undef PG8_BAR
#undef PG8_SCHED
}

typedef const f32x4 (&AccRef)[2][2][4][2];

struct EpiStoreBf16 {
    static constexpr bool PERM = true;
    bf16_t* O; int ldc; const float* bias;
    DI void operator()(AccRef acc, const Unit& u, int wr, int wc, int fr, int fq) const {
        const int row0 = u.pm * BM + wr * 64 + fr, col0 = u.pn * BM + wc * 32 + 8 * fq;
        f32x4 bv[2][2];
#pragma unroll
        for (int bj = 0; bj < 2; ++bj)
#pragma unroll
            for (int n = 0; n < 2; ++n) bv[bj][n] = bias ? *(const f32x4*)(bias + col0 + bj * HALF + 4 * n) : (f32x4){0.f, 0.f, 0.f, 0.f};
#pragma unroll
        for (int ai = 0; ai < 2; ++ai)
#pragma unroll
            for (int m = 0; m < 4; ++m) { bf16_t* rowp = O + u.ooff + (size_t)(row0 + ai * HALF + m * 16) * ldc + col0;
#pragma unroll
                for (int bj = 0; bj < 2; ++bj) { const f32x4 v0 = acc[ai][bj][m][0] + bv[bj][0], v1 = acc[ai][bj][m][1] + bv[bj][1];
                    u32x4 w; w.x = cvt_pk_bf16(v0[0], v0[1]); w.y = cvt_pk_bf16(v0[2], v0[3]); w.z = cvt_pk_bf16(v1[0], v1[1]); w.w = cvt_pk_bf16(v1[2], v1[3]);
                    *(u32x4*)(rowp + bj * HALF) = w; } }
    }
};
struct EpiStoreBf16H {
    static constexpr bool PERM = true;
    static constexpr int NSTORE = 8;
    bf16_t* O; int ldc; const float* bias;
    DI void operator()(AccRef acc, const Unit& u, int wr, int wc, int fr, int fq) const {
        const int row0 = u.pm * BM + wr * 64 + fr, col0 = u.pn * BM + (int)u.ooff + wc * 32 + 8 * fq;
        f32x4 bv[2];
#pragma unroll
        for (int n = 0; n < 2; ++n) bv[n] = bias ? *(const f32x4*)(bias + col0 + 4 * n) : (f32x4){0.f, 0.f, 0.f, 0.f};
#pragma unroll
        for (int ai = 0; ai < 2; ++ai)
#pragma unroll
            for (int m = 0; m < 4; ++m) { const f32x4 v0 = acc[ai][0][m][0] + bv[0], v1 = acc[ai][0][m][1] + bv[1];
                u32x4 w; w.x = cvt_pk_bf16(v0[0], v0[1]); w.y = cvt_pk_bf16(v0[2], v0[3]); w.z = cvt_pk_bf16(v1[0], v1[1]); w.w = cvt_pk_bf16(v1[2], v1[3]);
                *(u32x4*)(O + (size_t)(row0 + ai * HALF + m * 16) * ldc + col0) = w; }
    }
};
struct EpiSwiGLU {
    static constexpr bool PERM = true;
    bf16_t* H; int ldh;
    DI void operator()(AccRef acc, const Unit& u, int wr, int wc, int fr, int fq) const {
        const int row0 = u.pm * BM + wr * 64 + fr, col0 = u.pn * HALF + wc * 32 + 8 * fq;
#pragma unroll
        for (int ai = 0; ai < 2; ++ai)
#pragma unroll
            for (int m = 0; m < 4; ++m) { bf16_t* rowp = H + (size_t)(row0 + ai * HALF + m * 16) * ldh + col0;
                const f32x4 g0 = acc[ai][0][m][0], g1 = acc[ai][0][m][1], u0 = acc[ai][1][m][0], u1 = acc[ai][1][m][1];
                const f32x2 h0 = swiglu2((f32x2){g0[0], g0[1]}, (f32x2){u0[0], u0[1]}), h1 = swiglu2((f32x2){g0[2], g0[3]}, (f32x2){u0[2], u0[3]});
                const f32x2 h2 = swiglu2((f32x2){g1[0], g1[1]}, (f32x2){u1[0], u1[1]}), h3 = swiglu2((f32x2){g1[2], g1[3]}, (f32x2){u1[2], u1[3]});
                u32x4 w; w.x = cvt_pk_bf16(h0.x, h0.y); w.y = cvt_pk_bf16(h1.x, h1.y); w.z = cvt_pk_bf16(h2.x, h2.y); w.w = cvt_pk_bf16(h3.x, h3.y);
                *(u32x4*)rowp = w; }
    }
};
struct EpiSwiGLU8 {
    static constexpr bool PERM = true;
    unsigned char* H; size_t gs;
    DI void operator()(AccRef acc, const Unit& u, int wr, int wc, int fr, int fq) const {
        const int row0 = u.pm * BM + wr * 64 + fr;
        unsigned char* base = H + (size_t)(4 * u.pn + wc) * gs + 8 * fq;
#pragma unroll
        for (int ai = 0; ai < 2; ++ai)
#pragma unroll
            for (int m = 0; m < 4; ++m) { unsigned char* rowp = base + (size_t)(row0 + ai * HALF + m * 16) * 32;
                const f32x4 g0 = acc[ai][0][m][0], g1 = acc[ai][0][m][1], u0 = acc[ai][1][m][0], u1 = acc[ai][1][m][1];
                const f32x2 h0 = swiglu2((f32x2){g0[0], g0[1]}, (f32x2){u0[0], u0[1]}), h1 = swiglu2((f32x2){g0[2], g0[3]}, (f32x2){u0[2], u0[3]});
                const f32x2 h2 = swiglu2((f32x2){g1[0], g1[1]}, (f32x2){u1[0], u1[1]}), h3 = swiglu2((f32x2){g1[2], g1[3]}, (f32x2){u1[2], u1[3]});
                u32x2 w; w.x = cvt4_fp8(h0.x, h0.y, h1.x, h1.y); w.y = cvt4_fp8(h2.x, h2.y, h3.x, h3.y);
                *(u32x2*)rowp = w; }
    }
};
struct EpiResAdd {
    static constexpr bool PERM = true;
    bf16_t* X; const float* bias;
    DI void operator()(AccRef acc, const Unit& u, int wr, int wc, int fr, int fq) const {
        const int row0 = u.pm * BM + wr * 64 + fr, col0 = u.pn * BM + wc * 32 + 8 * fq;
        f32x4 bv[2][2];
#pragma unroll
        for (int bj = 0; bj < 2; ++bj)
#pragma unroll
            for (int n = 0; n < 2; ++n) bv[bj][n] = bias ? *(const f32x4*)(bias + col0 + bj * HALF + 4 * n) : (f32x4){0.f, 0.f, 0.f, 0.f};
        u32x4 xv[2][2];
#define RA_LOAD(r, buf) do { const bf16_t* rp_ = X + (size_t)(row0 + ((r) >> 2) * HALF + ((r) & 3) * 16) * D + col0; \
            _Pragma("unroll") for (int bj = 0; bj < 2; ++bj) xv[buf][bj] = *(const u32x4*)(rp_ + bj * HALF); } while (0)
        RA_LOAD(0, 0);
#pragma unroll
        for (int r = 0; r < 8; ++r) { const int ai = r >> 2, m = r & 3; bf16_t* rowp = X + (size_t)(row0 + ai * HALF + m * 16) * D + col0;
            if (r < 7) RA_LOAD(r + 1, (r + 1) & 1);
#pragma unroll
            for (int bj = 0; bj < 2; ++bj) { const u32x4 xw = xv[r & 1][bj]; const f32x4 a0 = acc[ai][bj][m][0] + bv[bj][0], a1 = acc[ai][bj][m][1] + bv[bj][1];
                u32x4 w; w.x = cvt_pk_bf16(bf_lo(xw.x) + a0[0], bf_hi(xw.x) + a0[1]); w.y = cvt_pk_bf16(bf_lo(xw.y) + a0[2], bf_hi(xw.y) + a0[3]);
                w.z = cvt_pk_bf16(bf_lo(xw.z) + a1[0], bf_hi(xw.z) + a1[1]); w.w = cvt_pk_bf16(bf_lo(xw.w) + a1[2], bf_hi(xw.w) + a1[3]);
                *(u32x4*)(rowp + bj * HALF) = w; }
            asm volatile("" ::: "memory"); }
#undef RA_LOAD
    }
};
struct EpiSloc {
    static constexpr bool PERM = false;
    float* SL;
    DI void operator()(AccRef acc, const Unit& u, int wr, int wc, int fr, int fq) const {
        const int row0 = u.pm * BM + wr * 64 + fr, col0 = wc * 32 + 4 * fq;
#pragma unroll
        for (int ai = 0; ai < 2; ++ai)
#pragma unroll
            for (int m = 0; m < 4; ++m) { float* rowp = SL + ((size_t)u.aux * S5ROWS + row0 + ai * HALF + m * 16) * 128 + col0;
#pragma unroll
                for (int n = 0; n < 2; ++n) *(f32x4*)(rowp + n * 16) = acc[ai][0][m][n]; }
    }
};
struct EpiS5Y {
    static constexpr bool PERM = true;
    bf16_t* Y;
    DI void operator()(AccRef acc, const Unit& u, int wr, int wc, int fr, int fq) const {
        const int g = u.aux, row0 = u.pm * BM + wr * 64 + fr, col0 = u.pn * BM + wc * 32 + 8 * fq, h0 = col0 & 15;
#pragma unroll
        for (int ai = 0; ai < 2; ++ai)
#pragma unroll
            for (int m = 0; m < 4; ++m) { const int R = row0 + ai * HALF + m * 16;
#pragma unroll
                for (int bj = 0; bj < 2; ++bj) { const int c = col0 + bj * HALF, l = c >> 4;
                    const f32x4 a0 = acc[ai][bj][m][0], a1 = acc[ai][bj][m][1];
                    const f32x2 y0 = gelu_tanh2((f32x2){a0[0], a0[1]}), y1 = gelu_tanh2((f32x2){a0[2], a0[3]}), y2 = gelu_tanh2((f32x2){a1[0], a1[1]}), y3 = gelu_tanh2((f32x2){a1[2], a1[3]});
                    u32x4 w; w.x = cvt_pk_bf16(y0.x, y0.y); w.y = cvt_pk_bf16(y1.x, y1.y); w.z = cvt_pk_bf16(y2.x, y2.y); w.w = cvt_pk_bf16(y3.x, y3.y);
                    *(u32x4*)(Y + ((size_t)g * T + (size_t)R * S5C + l) * 16 + h0) = w; } }
    }
};
template <bool XBF>
struct EpiGlu {
    static constexpr bool PERM = true;
    const void* XIN; bf16_t* XOUT; const bf16_t* Y; const float* bias;
    DI void operator()(AccRef acc, const Unit& u, int wr, int wc, int fr, int fq) const {
        const int row0 = u.pm * BM + wr * 64 + fr, col0 = u.pn * BM + wc * 32 + 8 * fq;
        f32x4 bv[2][2];
#pragma unroll
        for (int bj = 0; bj < 2; ++bj)
#pragma unroll
            for (int n = 0; n < 2; ++n) bv[bj][n] = *(const f32x4*)(bias + col0 + bj * HALF + 4 * n);
        f32x4 xf[2][2][2]; u32x4 xb[2][2], yw[2][2];
#define GL_LOAD(r, buf) do { const int row_ = row0 + ((r) >> 2) * HALF + ((r) & 3) * 16; \
            _Pragma("unroll") for (int bj = 0; bj < 2; ++bj) { const int cc = col0 + bj * HALF; \
                if constexpr (XBF) xb[buf][bj] = *(const u32x4*)((const bf16_t*)XIN + (size_t)row_ * D + cc); \
                else { xf[buf][bj][0] = *(const f32x4*)((const float*)XIN + (size_t)row_ * D + cc); xf[buf][bj][1] = *(const f32x4*)((const float*)XIN + (size_t)row_ * D + cc + 4); } \
                yw[buf][bj] = *(const u32x4*)(Y + ((size_t)(cc >> 4) * T + row_) * 16 + (cc & 15)); } } while (0)
        GL_LOAD(0, 0);
#pragma unroll
        for (int r = 0; r < 8; ++r) { const int ai = r >> 2, m = r & 3, b = r & 1; const size_t off = (size_t)(row0 + ai * HALF + m * 16) * D + col0;
            if (r < 7) GL_LOAD(r + 1, (r + 1) & 1);
#pragma unroll
            for (int bj = 0; bj < 2; ++bj) { const f32x4 z0 = acc[ai][bj][m][0] + bv[bj][0], z1 = acc[ai][bj][m][1] + bv[bj][1];
                const f32x2 s0 = sigmoid2((f32x2){z0[0], z0[1]}), s1 = sigmoid2((f32x2){z0[2], z0[3]}), s2 = sigmoid2((f32x2){z1[0], z1[1]}), s3 = sigmoid2((f32x2){z1[2], z1[3]});
                const u32x4 y = yw[b][bj]; f32x2 x0, x1, x2, x3;
                if constexpr (XBF) { const u32x4 x = xb[b][bj]; x0 = (f32x2){bf_lo(x.x), bf_hi(x.x)}; x1 = (f32x2){bf_lo(x.y), bf_hi(x.y)}; x2 = (f32x2){bf_lo(x.z), bf_hi(x.z)}; x3 = (f32x2){bf_lo(x.w), bf_hi(x.w)}; }
                else { const f32x4 xa = xf[b][bj][0], xc = xf[b][bj][1]; x0 = (f32x2){xa[0], xa[1]}; x1 = (f32x2){xa[2], xa[3]}; x2 = (f32x2){xc[0], xc[1]}; x3 = (f32x2){xc[2], xc[3]}; }
                const f32x2 o0 = x0 + (f32x2){bf_lo(y.x), bf_hi(y.x)} * s0, o1 = x1 + (f32x2){bf_lo(y.y), bf_hi(y.y)} * s1, o2 = x2 + (f32x2){bf_lo(y.z), bf_hi(y.z)} * s2, o3 = x3 + (f32x2){bf_lo(y.w), bf_hi(y.w)} * s3;
                *(u32x4*)(XOUT + off + bj * HALF) = (u32x4){cvt_pk_bf16(o0.x, o0.y), cvt_pk_bf16(o1.x, o1.y), cvt_pk_bf16(o2.x, o2.y), cvt_pk_bf16(o3.x, o3.y)}; }
            asm volatile("" ::: "memory"); }
#undef GL_LOAD
    }
};
}

#define XB_TMO      128
#define XB_XCNT(j)  (256  + 64 * (j))
#define XB_XSUB(j)  (1280 + 64 * (j))
#define XB_XGEN(j)  (2304 + 64 * (j))
#define XB_TOP      3328
#define XB_TOPGEN   3392
#define XCD_BAR_WORDS 3456
#define XB_SPIN_CAP (1u << 18)
__device__ __forceinline__ unsigned xb_ld(unsigned* p)              { return __hip_atomic_load(p, __ATOMIC_RELAXED, __HIP_MEMORY_SCOPE_AGENT); }
__device__ __forceinline__ unsigned xb_add(unsigned* p, unsigned v) { return __hip_atomic_fetch_add(p, v, __ATOMIC_RELAXED, __HIP_MEMORY_SCOPE_AGENT); }
__device__ __forceinline__ unsigned xb_xcc_id() { return (unsigned)__builtin_amdgcn_s_getreg((3 << 11) | 20) & 0xFu; }
#define XB_SPIN(cond, bar) do { unsigned _sp = 0; while (cond) { __builtin_amdgcn_s_sleep(1); \
    if ((++_sp & 255u) == 0u) { if (xb_ld(&(bar)[XB_TMO])) break; if (_sp > XB_SPIN_CAP) { atomicAdd(&(bar)[XB_TMO], 1u); break; } } } } while (0)
struct XcdBarrier { unsigned* bar; unsigned x; volatile LAS unsigned* st; };
__device__ __forceinline__ XcdBarrier xcd_barrier_post(unsigned* bar, volatile LAS unsigned* st) {
    XcdBarrier b; b.bar = bar; b.x = xb_xcc_id(); b.st = st;
    if (threadIdx.x == 0) (void)xb_add(&bar[XB_XCNT(b.x)], 1u);
    return b;
}
__device__ __forceinline__ void xcd_barrier_complete(unsigned* bar, unsigned x, unsigned& nloc, unsigned& nx) {
    const unsigned G = gridDim.x * gridDim.y * gridDim.z;
    unsigned sum, cnt, mine, sp = 0u;
    for (;;) {
        sum = 0u; cnt = 0u; mine = 0u;
#pragma unroll
        for (unsigned j = 0; j < 16; ++j) { const unsigned c = xb_ld(&bar[XB_XCNT(j)]); sum += c; cnt += (c > 0u) ? 1u : 0u; mine = (j == x) ? c : mine; }
        if (sum == G) break;
        __builtin_amdgcn_s_sleep(1);
        if ((++sp & 255u) == 0u) { if (xb_ld(&bar[XB_TMO])) break; if (sp > XB_SPIN_CAP) { atomicAdd(&bar[XB_TMO], 1u); break; } }
    }
    nloc = mine > 0u ? mine : 1u; nx = cnt > 0u ? cnt : 1u;
}
__device__ __forceinline__ void xcd_barrier(const XcdBarrier& b) {
    asm volatile("s_waitcnt vmcnt(0)" ::: "memory");
    __syncthreads();
    if (threadIdx.x == 0) {
        unsigned* bar = b.bar;
        __builtin_amdgcn_s_waitcnt(0);
        unsigned nloc = b.st[0], nx = b.st[1];
        if (nloc == 0u) { xcd_barrier_complete(bar, b.x, nloc, nx); b.st[0] = nloc; b.st[1] = nx; }
        const unsigned old = xb_add(&bar[XB_XSUB(b.x)], 1u);
        const unsigned gen = old / nloc;
        if (old + 1u == (gen + 1u) * nloc) {
            __builtin_amdgcn_fence(__ATOMIC_RELEASE, "agent");
            asm volatile("s_waitcnt vmcnt(0)" ::: "memory");
            const unsigned og = xb_add(&bar[XB_TOP], 1u);
            const unsigned tg = og / nx;
            if (og + 1u == (tg + 1u) * nx) xb_add(&bar[XB_TOPGEN], 1u);
            else XB_SPIN(xb_ld(&bar[XB_TOPGEN]) == tg, bar);
            __builtin_amdgcn_fence(__ATOMIC_ACQUIRE, "agent");
            xb_add(&bar[XB_XGEN(b.x)], 1u);
            asm volatile("s_waitcnt vmcnt(0)" ::: "memory");
        } else {
            XB_SPIN(xb_ld(&bar[XB_XGEN(b.x)]) == gen, bar);
            __builtin_amdgcn_fence(__ATOMIC_ACQUIRE, "agent");
            asm volatile("s_waitcnt vmcnt(0)" ::: "memory");
        }
    }
    __syncthreads();
}

struct Frame {
    LAS unsigned char* lds;
    int tid, lane, wave, G, gw, ngw;
};

struct RowId { DI int operator()(int n) const { return n; } };
struct RowGU { int hid; DI int operator()(int n) const { const int up = n >= hid ? 1 : 0, h = n - up * hid; return ((h >> 7) << 8) + (up << 7) + (h & 127); } };
template <bool FP8, class RowMap>
DI void convert_matrix_t(const Frame& F, const float* W, int K, int N, int ldn, void* WTv, int ldk, const RowMap& rm, int nbatch, size_t wstride, size_t tstride) {
    LAS float* scr = (LAS float*)(F.lds + F.wave * 16384);
    const int lane = F.lane, nblk = N / 32, per = (K / 64) * nblk, total = per * nbatch;
    f32x4 v[8];
#define CV_LOAD(it_) do { const int b_ = (it_) / per, r_ = (it_) % per; const float* src_ = W + (size_t)b_ * wstride + (size_t)(64 * (r_ / nblk) + (lane >> 3)) * ldn + 32 * (r_ % nblk) + 4 * (lane & 7); \
        _Pragma("unroll") for (int i = 0; i < 8; ++i) v[i] = *(const f32x4*)(src_ + (size_t)(8 * i) * ldn); } while (0)
    int it = F.gw;
    if (it < total) CV_LOAD(it);
    for (; it < total; it += F.ngw) {
        const int bb = it / per, r = it % per, k0 = 64 * (r / nblk), n0 = 32 * (r % nblk);
        { LAS float* dst = scr + (lane >> 3) * 33 + 4 * (lane & 7);
#pragma unroll
          for (int i = 0; i < 8; ++i) { dst[(8 * i) * 33 + 0] = v[i][0]; dst[(8 * i) * 33 + 1] = v[i][1]; dst[(8 * i) * 33 + 2] = v[i][2]; dst[(8 * i) * 33 + 3] = v[i][3]; } }
        asm volatile("" ::: "memory");
        if (it + F.ngw < total) CV_LOAD(it + F.ngw);
        LDS_WAIT(); asm volatile("" ::: "memory");
        const int c = lane & 7;
#pragma unroll
        for (int j = 0; j < 4; ++j) { const int n = (lane >> 3) + 8 * j; const LAS float* s = scr + (8 * c) * 33 + n;
            if constexpr (FP8) { u32x2 o; o.x = cvt4_fp8(s[0 * 33] * W8_SCALE, s[1 * 33] * W8_SCALE, s[2 * 33] * W8_SCALE, s[3 * 33] * W8_SCALE); o.y = cvt4_fp8(s[4 * 33] * W8_SCALE, s[5 * 33] * W8_SCALE, s[6 * 33] * W8_SCALE, s[7 * 33] * W8_SCALE);
                *(u32x2*)((unsigned char*)WTv + (size_t)bb * tstride + (size_t)rm(n0 + n) * ldk + k0 + 8 * c) = o; }
            else { u32x4 o; o.x = cvt_pk_bf16(s[0 * 33], s[1 * 33]); o.y = cvt_pk_bf16(s[2 * 33], s[3 * 33]); o.z = cvt_pk_bf16(s[4 * 33], s[5 * 33]); o.w = cvt_pk_bf16(s[6 * 33], s[7 * 33]);
                *(u32x4*)((bf16_t*)WTv + (size_t)bb * tstride + (size_t)rm(n0 + n) * ldk + k0 + 8 * c) = o; } }
        LDS_WAIT(); asm volatile("" ::: "memory");
    }
#undef CV_LOAD
}
template <class RowMap>
DI void convert_matrix(const Frame& F, const float* W, int K, int N, int ldn, bf16_t* WT, int ldk, const RowMap& rm, int nbatch, size_t wstride, size_t tstride) { convert_matrix_t<false>(F, W, K, N, ldn, WT, ldk, rm, nbatch, wstride, tstride); }
template <class RowMap>
DI void convert_matrix8(const Frame& F, const float* W, int K, int N, int ldn, unsigned char* WT, int ldk, const RowMap& rm, int nbatch, size_t wstride, size_t tstride) { convert_matrix_t<true>(F, W, K, N, ldn, WT, ldk, rm, nbatch, wstride, tstride); }

DI void load_row(const float* xrow, int lane, f32x4 (&v)[4]) {
#pragma unroll
    for (int j = 0; j < 4; ++j) v[j] = *(const f32x4*)(xrow + 4 * lane + 256 * j);
}
DI void load_row(const bf16_t* xrow, int lane, f32x4 (&v)[4]) {
#pragma unroll
    for (int j = 0; j < 4; ++j) { const u32x2 w = *(const u32x2*)(xrow + 4 * lane + 256 * j); v[j] = (f32x4){bf_lo(w.x), bf_hi(w.x), bf_lo(w.y), bf_hi(w.y)}; }
}
DI float row_rstd(const f32x4 (&v)[4]) {
    float s = 0.f;
#pragma unroll
    for (int j = 0; j < 4; ++j) s += (v[j][0] * v[j][0] + v[j][1] * v[j][1]) + (v[j][2] * v[j][2] + v[j][3] * v[j][3]);
    return rsqrtf(wave_sum(s) * (1.f / D) + EPS);
}
template <bool FP8 = false>
DI void norm_phase(const Frame& F, const bf16_t* X, const float* gain, bf16_t* XN) {
    f32x4 gv[4]; load_row(gain, F.lane, gv);
    f32x4 vn[4]; if (F.gw < T) load_row(X + (size_t)F.gw * D, F.lane, vn);
    for (int t = F.gw; t < T; t += F.ngw) {
        f32x4 v[4];
#pragma unroll
        for (int j = 0; j < 4; ++j) v[j] = vn[j];
        if (t + F.ngw < T) load_row(X + (size_t)(t + F.ngw) * D, F.lane, vn);
        const float rs = row_rstd(v);
#pragma unroll
        for (int j = 0; j < 4; ++j) {
            if constexpr (FP8) { *(unsigned*)((unsigned char*)XN + (size_t)t * D + 4 * F.lane + 256 * j) = cvt4_fp8(v[j][0] * rs * gv[j][0], v[j][1] * rs * gv[j][1], v[j][2] * rs * gv[j][2], v[j][3] * rs * gv[j][3]); }
            else { u32x2 w; w.x = cvt_pk_bf16(v[j][0] * rs * gv[j][0], v[j][1] * rs * gv[j][1]); w.y = cvt_pk_bf16(v[j][2] * rs * gv[j][2], v[j][3] * rs * gv[j][3]);
                *(u32x2*)(XN + (size_t)t * D + 4 * F.lane + 256 * j) = w; } }
    }
}
template <class XT>
DI void norm_to_ug_phase(const Frame& F, const XT* X, const float* gain, bf16_t* UG, bf16_t* XB) {
    f32x4 gv[4];
#pragma unroll
    for (int j = 0; j < 4; ++j) gv[j] = *(const f32x4*)(gain + 16 * F.lane + 4 * j);
    constexpr int NCH = T / S5C, TS = 2080;
    LAS unsigned char* st = F.lds;
    for (int ch = blockIdx.x; ch < NCH; ch += F.G) {
        f32x4 v[4][4];
#pragma unroll
        for (int i = 0; i < 4; ++i)
#pragma unroll
            for (int j = 0; j < 4; ++j) { const XT* src = X + (size_t)(ch * S5C + 4 * F.wave + i) * D + 16 * F.lane + 4 * j;
                if constexpr (sizeof(XT) == 4) v[i][j] = *(const f32x4*)src; else { const u32x2 w = *(const u32x2*)src; v[i][j] = (f32x4){bf_lo(w.x), bf_hi(w.x), bf_lo(w.y), bf_hi(w.y)}; } }
#pragma unroll
        for (int i = 0; i < 4; ++i) { const float rs = row_rstd(v[i]); unsigned w[8];
#pragma unroll
            for (int j = 0; j < 4; ++j) { w[2 * j] = cvt_pk_bf16(v[i][j][0] * rs * gv[j][0], v[i][j][1] * rs * gv[j][1]); w[2 * j + 1] = cvt_pk_bf16(v[i][j][2] * rs * gv[j][2], v[i][j][3] * rs * gv[j][3]); }
            if constexpr (sizeof(XT) == 4) { bf16_t* xb = XB + (size_t)(ch * S5C + 4 * F.wave + i) * D + 16 * F.lane;
                *(u32x4*)xb = (u32x4){cvt_pk_bf16(v[i][0][0], v[i][0][1]), cvt_pk_bf16(v[i][0][2], v[i][0][3]), cvt_pk_bf16(v[i][1][0], v[i][1][1]), cvt_pk_bf16(v[i][1][2], v[i][1][3])};
                *(u32x4*)(xb + 8) = (u32x4){cvt_pk_bf16(v[i][2][0], v[i][2][1]), cvt_pk_bf16(v[i][2][2], v[i][2][3]), cvt_pk_bf16(v[i][3][0], v[i][3][1]), cvt_pk_bf16(v[i][3][2], v[i][3][3])}; }
            LAS unsigned char* dl = st + (4 * F.wave + i) * TS + F.lane * 32;
            *(LAS u32x4*)dl = (u32x4){w[0], w[1], w[2], w[3]}; *(LAS u32x4*)(dl + 16) = (u32x4){w[4], w[5], w[6], w[7]}; }
        __syncthreads();
#pragma unroll
        for (int k = 0; k < 8; ++k) { const int g = 8 * F.wave + k;
            const u32x4 o = *(const LAS u32x4*)(st + (F.lane >> 1) * TS + g * 32 + (F.lane & 1) * 16);
            *(u32x4*)(UG + ((size_t)g * S5ROWS + ch) * S5LD + 8 * F.lane) = o; }
        __syncthreads();
    }
}

struct S5P { const float *lam_re, *lam_im, *log_dt, *b_re, *b_im, *c_re, *c_im, *dskip, *w_glu, *b_glu; };
DI void s5_tables_phase(const Frame& F, const S5P& p, bf16_t* TG, bf16_t* FG) {
    LAS f32x2* pw = (LAS f32x2*)(F.lds);
    LAS f32x2* bb = (LAS f32x2*)(F.lds + 16896);
    LAS f32x2* cc = (LAS f32x2*)(F.lds + 25088);
    LAS float* kt = (LAS float*)(F.lds + 33280);
    LAS f32x2* cct = (LAS f32x2*)(F.lds + 67584);
    const int tid = F.tid;
    for (int unit = blockIdx.x; unit < 256; unit += F.G) {
        const int g = unit >> 2, q = unit & 3;
        const float dt = expf(p.log_dt[g]);
        for (int i = tid; i < 33 * 64; i += NTHR) { const int tau = i >> 6, pp = i & 63; const float lre = p.lam_re[g * 64 + pp], lim = p.lam_im[g * 64 + pp];
            const float mag = __expf((float)tau * dt * lre), rev = __builtin_amdgcn_fractf((float)tau * (dt * lim * 0.15915494309189535f)); pw[i] = (f32x2){mag * __builtin_amdgcn_cosf(rev), mag * __builtin_amdgcn_sinf(rev)}; }
        for (int i = tid; i < 1024; i += NTHR) { const int pp = i >> 4, hi = i & 15; const float lre = p.lam_re[g * 64 + pp], lim = p.lam_im[g * 64 + pp];
            const float mag = __expf(dt * lre), rev = __builtin_amdgcn_fractf(dt * lim * 0.15915494309189535f), nr = mag * __builtin_amdgcn_cosf(rev) - 1.f, ni = mag * __builtin_amdgcn_sinf(rev), den = __builtin_amdgcn_rcpf(lre * lre + lim * lim);
            const float cr = (nr * lre + ni * lim) * den, ci = (ni * lre - nr * lim) * den;
            const float br = p.b_re[(size_t)(g * 64 + pp) * 16 + hi], bi = p.b_im[(size_t)(g * 64 + pp) * 16 + hi];
            bb[i] = (f32x2){cr * br - ci * bi, cr * bi + ci * br}; }
        for (int i = tid; i < 1024; i += NTHR) { const int ho = i >> 6, pp = i & 63; const f32x2 cv = (f32x2){p.c_re[(size_t)(g * 16 + ho) * 64 + pp], p.c_im[(size_t)(g * 16 + ho) * 64 + pp]}; cc[i] = cv; cct[pp * 16 + ho] = cv; }
        __syncthreads();
        {
          const int tau = tid >> 4, ho0 = ((tid >> 2) & 3) * 4, hi0 = (tid & 3) * 4;
          float acc[4][4];
#pragma unroll
          for (int i = 0; i < 4; ++i)
#pragma unroll
              for (int j = 0; j < 4; ++j) acc[i][j] = 0.f;
#pragma unroll 2
          for (int pp = 0; pp < 64; ++pp) { const f32x2 a = pw[tau * 64 + pp];
              const f32x4 b01 = *(const LAS f32x4*)(bb + pp * 16 + hi0), b23 = *(const LAS f32x4*)(bb + pp * 16 + hi0 + 2);
              const float br[4] = {b01[0], b01[2], b23[0], b23[2]}, bi[4] = {b01[1], b01[3], b23[1], b23[3]};
              const f32x4 c01 = *(const LAS f32x4*)(cct + pp * 16 + ho0), c23 = *(const LAS f32x4*)(cct + pp * 16 + ho0 + 2);
              const float cr[4] = {c01[0], c01[2], c23[0], c23[2]}, ci[4] = {c01[1], c01[3], c23[1], c23[3]};
#pragma unroll
              for (int i = 0; i < 4; ++i) { const float zr = cr[i] * a.x - ci[i] * a.y, zi = cr[i] * a.y + ci[i] * a.x;
#pragma unroll
                  for (int j = 0; j < 4; ++j) acc[i][j] += zr * br[j] - zi * bi[j]; } }
          if (tau == 0 && ho0 == hi0) {
#pragma unroll
              for (int i = 0; i < 4; ++i) acc[i][i] += p.dskip[g * 16 + ho0 + i]; }
#pragma unroll
          for (int i = 0; i < 4; ++i) *(LAS f32x4*)(kt + tau * 264 + (ho0 + i) * 16 + hi0) = (f32x4){acc[i][0], acc[i][1], acc[i][2], acc[i][3]}; }
        __syncthreads();
        for (int nl = F.wave; nl < 128; nl += NWAVES) for (int ck = F.lane; ck < 80; ck += 64) { const int n = 128 * q + nl, l = n >> 4, ho = n & 15, k0 = 8 * ck; float v[8];
            if (k0 < S5K) { const int lp = k0 >> 4, hi0 = k0 & 15;
#pragma unroll
                for (int j = 0; j < 8; ++j) v[j] = (lp <= l) ? kt[(l - lp) * 264 + ho * 16 + hi0 + j] : 0.f; }
            else if (k0 < S5K + 64) { const int p0 = k0 - S5K;
#pragma unroll
                for (int j = 0; j < 8; ++j) { const f32x2 c = cc[ho * 64 + p0 + j], a = pw[(l + 1) * 64 + p0 + j]; v[j] = c.x * a.x - c.y * a.y; } }
            else { const int p0 = k0 - S5K - 64;
#pragma unroll
                for (int j = 0; j < 8; ++j) { const f32x2 c = cc[ho * 64 + p0 + j], a = pw[(l + 1) * 64 + p0 + j]; v[j] = -(c.x * a.y + c.y * a.x); } }
            *(u32x4*)(TG + ((size_t)g * S5K + n) * S5LD + k0) = (u32x4){cvt_pk_bf16(v[0], v[1]), cvt_pk_bf16(v[2], v[3]), cvt_pk_bf16(v[4], v[5]), cvt_pk_bf16(v[6], v[7])}; }
        for (int ch = tid; ch < 32 * 64; ch += NTHR) { const int nl = ch >> 6, ck = ch & 63, n = 32 * q + nl, pp = n & 63, k0 = 8 * ck, lp = k0 >> 4, hi0 = k0 & 15, tau = S5C - 1 - lp; float v[8];
            const f32x2 a = pw[tau * 64 + pp];
#pragma unroll
            for (int j = 0; j < 8; ++j) { const f32x2 b = bb[pp * 16 + hi0 + j]; v[j] = (n < 64) ? (a.x * b.x - a.y * b.y) : (a.x * b.y + a.y * b.x); }
            *(u32x4*)(FG + ((size_t)g * 256 + n) * S5K + k0) = (u32x4){cvt_pk_bf16(v[0], v[1]), cvt_pk_bf16(v[2], v[3]), cvt_pk_bf16(v[4], v[5]), cvt_pk_bf16(v[6], v[7])}; }
        __syncthreads();
    }
}
DI void s5_scan_tile(const Frame& F, const S5P& p, const float* SLOC, bf16_t* UG, int g, int pm) {
    if (F.tid < 256) {
        const int pp = F.tid & 63, b = 4 * pm + (F.tid >> 6);
        const float dt = expf(p.log_dt[g]), lre = p.lam_re[g * 64 + pp], lim = p.lam_im[g * 64 + pp];
        const float mag = __expf((float)S5C * dt * lre), rev = __builtin_amdgcn_fractf((float)S5C * (dt * lim * 0.15915494309189535f)), ar = mag * __builtin_amdgcn_cosf(rev), ai = mag * __builtin_amdgcn_sinf(rev);
        float sr = 0.f, si = 0.f;
        const int nch = SEQ / S5C;
#pragma unroll 16
        for (int c = 0; c < nch; ++c) { const size_t R = (size_t)g * S5ROWS + b * nch + c;
            UG[R * S5LD + S5K + pp] = f2bf(sr); UG[R * S5LD + S5K + 64 + pp] = f2bf(si);
            const float lr = SLOC[R * 128 + pp], li = SLOC[R * 128 + 64 + pp];
            const float nr = ar * sr - ai * si + lr, ni = ar * si + ai * sr + li; sr = nr; si = ni; }
    }
}
DI void s5_scan_phase(const Frame& F, const S5P& p, const float* SLOC, bf16_t* UG) {
    const int gt = blockIdx.x * NTHR + F.tid, nth = F.G * NTHR;
    for (int id = gt; id < 64 * BATCH * 64; id += nth) {
        const int pp = id & 63, b = (id >> 6) & 15, g = id >> 10;
        const float dt = expf(p.log_dt[g]), lre = p.lam_re[g * 64 + pp], lim = p.lam_im[g * 64 + pp];
        const float mag = __expf((float)S5C * dt * lre), rev = __builtin_amdgcn_fractf((float)S5C * (dt * lim * 0.15915494309189535f)), ar = mag * __builtin_amdgcn_cosf(rev), ai = mag * __builtin_amdgcn_sinf(rev);
        float sr = 0.f, si = 0.f;
        const int nch = SEQ / S5C;
#pragma unroll 16
        for (int c = 0; c < nch; ++c) { const size_t R = (size_t)g * S5ROWS + b * nch + c;
            UG[R * S5LD + S5K + pp] = f2bf(sr); UG[R * S5LD + S5K + 64 + pp] = f2bf(si);
            const float lr = SLOC[R * 128 + pp], li = SLOC[R * 128 + 64 + pp];
            const float nr = ar * sr - ai * si + lr, ni = ar * si + ai * sr + li; sr = nr; si = ni; }
    }
}

DI void gla_prep_phase(const Frame& F, const bf16_t* PROJ, const float* wg2, const float* bg2, bf16_t* QSB, bf16_t* KE, bf16_t* SCB, float* DECG) {
    constexpr int QS = 0, KS = 17408, KET = 34816, SC = 53248, VT = 62464, GLOW = 99328, WG2 = 103424, QSUM = 111616, BG = 113664;
    LAS unsigned char* lds = F.lds;
    const int tid = F.tid, lane = F.lane, w = F.wave, q4 = lane >> 4, r16 = lane & 15;
    const int d = tid & 127, tq = __builtin_amdgcn_readfirstlane(tid >> 7);
    int hprev = -1;
    u32x4 pq[2], pk[2], pg; pg = (u32x4){0u, 0u, 0u, 0u};
#define GLP_ISSUE(uu) do { const int h_ = (uu) & 3; const size_t tk0 = (size_t)((uu) >> 7) * SEQ + (((uu) >> 2) & 31) * 64; \
        _Pragma("unroll") for (int i = 0; i < 2; ++i) { const int id = tid + NTHR * i; const bf16_t* src = PROJ + (tk0 + (id >> 4)) * GLA_N + h_ * 128 + (id & 15) * 8; pq[i] = *(const u32x4*)src; pk[i] = *(const u32x4*)(src + 512); } \
        if (tid < 128) pg = *(const u32x4*)(PROJ + (tk0 + (tid >> 1)) * GLA_N + 3072 + (tid & 1) * 8); } while (0)
    if ((int)blockIdx.x < 2048) GLP_ISSUE((int)blockIdx.x);
    for (int u = blockIdx.x; u < 2048; u += F.G) {
        const int h = u & 3;
        if (h != hprev) { for (int i = tid; i < 2048; i += NTHR) ((LAS float*)(lds + WG2))[i] = wg2[(i >> 7) * 512 + h * 128 + (i & 127)];
            if (tid < 128) ((LAS float*)(lds + BG))[tid] = bg2[h * 128 + tid]; hprev = h; }
#pragma unroll
        for (int i = 0; i < 2; ++i) { const int id = tid + NTHR * i, row = id >> 4, c8 = id & 15; *(LAS u32x4*)(lds + QS + row * 272 + c8 * 16) = pq[i]; *(LAS u32x4*)(lds + KS + row * 272 + c8 * 16) = pk[i]; }
        if (tid < 128) { const int row = tid >> 1, hf = tid & 1; LAS float* gl = (LAS float*)(lds + GLOW) + row * 16 + hf * 8;
            gl[0] = bf_lo(pg.x); gl[1] = bf_hi(pg.x); gl[2] = bf_lo(pg.y); gl[3] = bf_hi(pg.y); gl[4] = bf_lo(pg.z); gl[5] = bf_hi(pg.z); gl[6] = bf_lo(pg.w); gl[7] = bf_hi(pg.w); }
        LDS_BARRIER();
        if (u + F.G < 2048) GLP_ISSUE(u + F.G);
        float cum[16];
        { float wcol[16];
#pragma unroll
          for (int r = 0; r < 16; ++r) wcol[r] = ((LAS float*)(lds + WG2))[r * 128 + d];
          const float bcol = ((LAS float*)(lds + BG))[d]; float run = 0.f;
#pragma unroll
          for (int i = 0; i < 16; ++i) { const LAS f32x4* gl = (const LAS f32x4*)(lds + GLOW + (tq * 16 + i) * 64); float z = bcol;
#pragma unroll
              for (int r4 = 0; r4 < 4; ++r4) { const f32x4 gq = gl[r4]; z += gq[0] * wcol[4 * r4] + gq[1] * wcol[4 * r4 + 1] + gq[2] * wcol[4 * r4 + 2] + gq[3] * wcol[4 * r4 + 3]; }
              const float ls = fminf(z, 0.f) - __logf(1.f + __expf(-fabsf(z))); run += ls * (1.f / 16.f); cum[i] = run; }
          ((LAS float*)(lds + QSUM))[tq * 128 + d] = run; }
        LDS_BARRIER();
        { float off = 0.f, glast = 0.f;
#pragma unroll
          for (int t4 = 0; t4 < 4; ++t4) { const float qv = ((LAS float*)(lds + QSUM))[t4 * 128 + d]; glast += qv; if (t4 < tq) off += qv; }
          const float dec = __expf(glast);
          unsigned ke[8];
#pragma unroll
          for (int i = 0; i < 16; i += 2) { float kend[2];
#pragma unroll
              for (int ii = 0; ii < 2; ++ii) { const int tok = tq * 16 + i + ii; const float eg = __expf(off + cum[i + ii]), eng = __builtin_amdgcn_rcpf(eg);
                  LAS bf16_t* qp = (LAS bf16_t*)(lds + QS + tok * 272 + d * 2); LAS bf16_t* kp = (LAS bf16_t*)(lds + KS + tok * 272 + d * 2);
                  const float qv = bf2f(*qp), ks = bf2f(*kp) * eng;
                  *qp = f2bf(qv * 0.08838834764831845f * eg); *kp = f2bf(ks); kend[ii] = ks * dec; }
              ke[i >> 1] = cvt_pk_bf16(kend[0], kend[1]); }
          *(LAS u32x4*)(lds + KET + d * 144 + tq * 32) = (u32x4){ke[0], ke[1], ke[2], ke[3]}; *(LAS u32x4*)(lds + KET + d * 144 + tq * 32 + 16) = (u32x4){ke[4], ke[5], ke[6], ke[7]};
          if (tq == 0) DECG[(size_t)u * 128 + d] = dec; }
        LDS_BARRIER();
        { const int it = w >> 1;
#pragma unroll
          for (int jj = 0; jj < 2; ++jj) { const int jt = 2 * (w & 1) + jj; f32x4 a = (f32x4){0.f, 0.f, 0.f, 0.f};
              if (jt <= it) {
#pragma unroll
                  for (int ks = 0; ks < 4; ++ks) { const bf16x8 af = *(const LAS bf16x8*)(lds + QS + (16 * it + r16) * 272 + (ks * 32 + q4 * 8) * 2), bfr = *(const LAS bf16x8*)(lds + KS + (16 * jt + r16) * 272 + (ks * 32 + q4 * 8) * 2);
                      a = __builtin_amdgcn_mfma_f32_16x16x32_bf16(af, bfr, a, 0, 0, 0); } }
#pragma unroll
              for (int rr = 0; rr < 4; ++rr) { const int i = 16 * it + 4 * q4 + rr, j = 16 * jt + r16; *(LAS bf16_t*)(lds + SC + i * 144 + j * 2) = f2bf(j <= i ? a[rr] : 0.f); } } }
        LDS_BARRIER();
#pragma unroll
        for (int i = 0; i < 2; ++i) { const int id = tid + NTHR * i, row = id >> 4, c8 = id & 15; *(u32x4*)(QSB + (size_t)u * 8192 + (size_t)id * 8) = *(const LAS u32x4*)(lds + QS + row * 272 + c8 * 16); }
#pragma unroll
        for (int i = 0; i < 2; ++i) { const int id = tid + NTHR * i, row = id >> 3, c8 = id & 7; *(u32x4*)(KE + (size_t)u * 8192 + (size_t)id * 8) = *(const LAS u32x4*)(lds + KET + row * 144 + c8 * 16); }
        { const int row = tid >> 3, c8 = tid & 7; *(u32x4*)(SCB + (size_t)u * 4096 + (size_t)tid * 8) = *(const LAS u32x4*)(lds + SC + row * 144 + c8 * 16); }
        LDS_BARRIER();
    }
#undef GLP_ISSUE
}
DI void gla_glow_phase(const Frame& F, const bf16_t* XN, const bf16_t* WG, bf16_t* PROJ) {
    LAS unsigned char* wl = F.lds;
    for (int i = F.tid; i < 16 * 128; i += NTHR) { const int r = i >> 7, cc = i & 127; *(LAS u32x4*)(wl + r * 2064 + cc * 16) = *(const u32x4*)(WG + (size_t)r * D + cc * 8); }
    __syncthreads();
    const int r16 = F.lane & 15, q4 = F.lane >> 4;
    for (int tile = F.gw; tile < T / 16; tile += F.ngw) {
        const bf16_t* xr = XN + (size_t)(tile * 16 + r16) * D + q4 * 8;
        bf16x8 xa[32];
#pragma unroll
        for (int ks = 0; ks < 32; ++ks) xa[ks] = *(const bf16x8*)(xr + ks * 32);
        f32x4 a = (f32x4){0.f, 0.f, 0.f, 0.f};
#pragma unroll
        for (int ks = 0; ks < 32; ++ks) { const bf16x8 wb = *(const LAS bf16x8*)(wl + r16 * 2064 + (ks * 32 + q4 * 8) * 2); a = __builtin_amdgcn_mfma_f32_16x16x32_bf16(wb, xa[ks], a, 0, 0, 0); }
        *(u32x2*)(PROJ + (size_t)(tile * 16 + r16) * GLA_N + 3072 + 4 * q4) = (u32x2){cvt_pk_bf16(a[0], a[1]), cvt_pk_bf16(a[2], a[3])};
    }
    __syncthreads();
}
DI void gla_seq_phase(const Frame& F, const bf16_t* QSB, const bf16_t* KE, const bf16_t* SCB, const bf16_t* PROJ, const float* DECG, bf16_t* GO) {
    constexpr int BUF = 54784, QS = 0, KET = 17408, VT = 35840, SC = 45056, DEC = 54272, ST0 = 2 * BUF, STB = 17408;
    LAS unsigned char* lds = F.lds;
    const int tid = F.tid, lane = F.lane, w = F.wave, q4 = lane >> 4, r16 = lane & 15;
    const int vtb = (8 * q4 + ((lane >> 2) & 3)) * 144 + (lane & 3) * 8;
    for (int ui = blockIdx.x; ui < 256; ui += F.G) {
        const int unit = (F.G == 256) ? (((ui & 7) << 5) | (ui >> 3)) : ui;
        const int b = unit >> 4, h = (unit >> 2) & 3, s = unit & 3;
        for (int i = tid; i < STB / 4; i += NTHR) ((LAS unsigned*)(lds + ST0))[i] = 0u;
        f32x4 st[4];
#pragma unroll
        for (int e = 0; e < 4; ++e) st[e] = (f32x4){0.f, 0.f, 0.f, 0.f};
        u32x4 rA[7], rB[7];
        rA[6] = (u32x4){0u, 0u, 0u, 0u}; rB[6] = (u32x4){0u, 0u, 0u, 0u};
#define GLA_ISSUE(R, nn) do { const size_t uu = (size_t)b * 128 + (nn) * 4 + h; \
            _Pragma("unroll") for (int i = 0; i < 2; ++i) { const int id = tid + NTHR * i; R[i] = *(const u32x4*)(QSB + uu * 8192 + (size_t)id * 8); R[2 + i] = *(const u32x4*)(KE + uu * 8192 + (size_t)id * 8); } \
            R[4] = *(const u32x4*)(PROJ + ((size_t)b * SEQ + (nn) * 64 + (tid >> 3)) * GLA_N + 1024 + h * 256 + s * 64 + (tid & 7) * 8); R[5] = *(const u32x4*)(SCB + uu * 4096 + (size_t)tid * 8); \
            if (tid < 32) R[6] = *(const u32x4*)(DECG + uu * 128 + tid * 4); } while (0)
#define GLA_TO_LDS(R, bufb) do { _Pragma("unroll") for (int i = 0; i < 2; ++i) { const int id = tid + NTHR * i; *(LAS u32x4*)((bufb) + QS + (id >> 4) * 272 + (id & 15) * 16) = R[i]; *(LAS u32x4*)((bufb) + KET + (id >> 3) * 144 + (id & 7) * 16) = R[2 + i]; } \
            *(LAS u32x4*)((bufb) + VT + (tid >> 3) * 144 + (tid & 7) * 16) = R[4]; *(LAS u32x4*)((bufb) + SC + (tid >> 3) * 144 + (tid & 7) * 16) = R[5]; \
            if (tid < 32) *(LAS u32x4*)((bufb) + DEC + tid * 16) = R[6]; } while (0)
#define GLA_VTR(bufb_, et_, ks_) __builtin_shufflevector(__builtin_amdgcn_ds_read_tr16_b64_v4i16((LAS s16x4*)((bufb_) + VT + vtb + (ks_) * (32 * 144) + (et_) * 32)), \
            __builtin_amdgcn_ds_read_tr16_b64_v4i16((LAS s16x4*)((bufb_) + VT + vtb + (ks_) * (32 * 144) + (et_) * 32 + 4 * 144)), 0, 1, 2, 3, 4, 5, 6, 7)
#define GLA_STEP(n) do { const size_t tok0 = (size_t)b * SEQ + (n) * 64; \
            const LAS unsigned char* bufb = lds + ((n) & 1) * BUF; const LAS unsigned char* stc = lds + ST0 + ((n) & 1) * STB; LAS unsigned char* stn = lds + ST0 + (((n) + 1) & 1) * STB; \
            const int fo = q4 * 16; \
            { const int tt = w >> 1; bf16x8 bs[2], bq[4]; \
              _Pragma("unroll") for (int ks = 0; ks < 2; ++ks) bs[ks] = *(const LAS bf16x8*)(bufb + SC + (16 * tt + r16) * 144 + ks * 64 + fo); \
              _Pragma("unroll") for (int ks = 0; ks < 4; ++ks) bq[ks] = *(const LAS bf16x8*)(bufb + QS + (16 * tt + r16) * 272 + ks * 64 + fo); \
              _Pragma("unroll") for (int ee = 0; ee < 2; ++ee) { const int et = 2 * (w & 1) + ee; f32x4 a = (f32x4){0.f, 0.f, 0.f, 0.f}; \
                  _Pragma("unroll") for (int ks = 0; ks < 2; ++ks) { const bf16x8 av = GLA_VTR(bufb, et, ks); a = __builtin_amdgcn_mfma_f32_16x16x32_bf16(av, bs[ks], a, 0, 0, 0); } \
                  _Pragma("unroll") for (int ks = 0; ks < 4; ++ks) { const bf16x8 as = *(const LAS bf16x8*)(stc + (16 * et + r16) * 272 + ks * 64 + fo); a = __builtin_amdgcn_mfma_f32_16x16x32_bf16(as, bq[ks], a, 0, 0, 0); } \
                  *(u32x2*)(GO + (tok0 + 16 * tt + r16) * D + h * 256 + s * 64 + 16 * et + 4 * q4) = (u32x2){cvt_pk_bf16(a[0], a[1]), cvt_pk_bf16(a[2], a[3])}; } } \
            { bf16x8 ak[2]; \
              _Pragma("unroll") for (int ks = 0; ks < 2; ++ks) ak[ks] = *(const LAS bf16x8*)(bufb + KET + (16 * w + r16) * 144 + ks * 64 + fo); \
              const f32x4 dec = *(const LAS f32x4*)(bufb + DEC + (16 * w + 4 * q4) * 4); \
              _Pragma("unroll") for (int et = 0; et < 4; ++et) { st[et] = st[et] * dec; \
                  _Pragma("unroll") for (int ks = 0; ks < 2; ++ks) { const bf16x8 bv = GLA_VTR(bufb, et, ks); st[et] = __builtin_amdgcn_mfma_f32_16x16x32_bf16(ak[ks], bv, st[et], 0, 0, 0); } \
                  *(LAS u32x2*)(stn + (16 * et + r16) * 272 + (16 * w + 4 * q4) * 2) = (u32x2){cvt_pk_bf16(st[et][0], st[et][1]), cvt_pk_bf16(st[et][2], st[et][3])}; } } } while (0)
        GLA_ISSUE(rA, 0); GLA_ISSUE(rB, 1); GLA_TO_LDS(rA, lds); GLA_ISSUE(rA, 2);
        LDS_BARRIER();
        for (int n = 0; n < 32; n += 2) {
            asm volatile("" ::: "memory");
            GLA_STEP(n);
            GLA_TO_LDS(rB, lds + BUF);
            if (n + 3 < 32) GLA_ISSUE(rB, n + 3);
            LDS_BARRIER();
            asm volatile("" ::: "memory");
            GLA_STEP(n + 1);
            if (n + 2 < 32) { GLA_TO_LDS(rA, lds); }
            if (n + 4 < 32) GLA_ISSUE(rA, n + 4);
            LDS_BARRIER();
        }
#undef GLA_ISSUE
#undef GLA_TO_LDS
#undef GLA_STEP
#undef GLA_VTR
    }
}
DI void gla_finalize_phase(const Frame& F, const bf16_t* GO, const bf16_t* PROJ, const float* gnorm, bf16_t* OG) {
    f32x4 gv[4];
#pragma unroll
    for (int j = 0; j < 4; ++j) gv[j] = *(const f32x4*)(gnorm + 16 * F.lane + 4 * j);
    for (int t = F.gw; t < T; t += F.ngw) {
        const u32x4 o0 = *(const u32x4*)(GO + (size_t)t * D + 16 * F.lane), o1 = *(const u32x4*)(GO + (size_t)t * D + 16 * F.lane + 8);
        const u32x4 r0 = *(const u32x4*)(PROJ + (size_t)t * GLA_N + 2048 + 16 * F.lane), r1 = *(const u32x4*)(PROJ + (size_t)t * GLA_N + 2048 + 16 * F.lane + 8);
        const unsigned ow[8] = {o0.x, o0.y, o0.z, o0.w, o1.x, o1.y, o1.z, o1.w}, rw[8] = {r0.x, r0.y, r0.z, r0.w, r1.x, r1.y, r1.z, r1.w};
        float o[16], ss = 0.f;
#pragma unroll
        for (int j = 0; j < 8; ++j) { o[2 * j] = bf_lo(ow[j]); o[2 * j + 1] = bf_hi(ow[j]); ss += o[2 * j] * o[2 * j] + o[2 * j + 1] * o[2 * j + 1]; }
        ss += __shfl_xor(ss, 1); ss += __shfl_xor(ss, 2); ss += __shfl_xor(ss, 4); ss += __shfl_xor(ss, 8);
        const float rs = rsqrtf(ss * (1.f / 256.f) + EPS);
        unsigned w[8];
#pragma unroll
        for (int j = 0; j < 8; ++j) { const float ra = bf_lo(rw[j]), rb = bf_hi(rw[j]); w[j] = cvt_pk_bf16(o[2 * j] * rs * gv[j >> 1][(2 * j) & 3] * silu_f(ra), o[2 * j + 1] * rs * gv[j >> 1][(2 * j + 1) & 3] * silu_f(rb)); }
        *(u32x4*)(OG + (size_t)t * D + 16 * F.lane) = (u32x4){w[0], w[1], w[2], w[3]}; *(u32x4*)(OG + (size_t)t * D + 16 * F.lane + 8) = (u32x4){w[4], w[5], w[6], w[7]};
    }
}

DI void swa_phase(const Frame& F, const bf16_t* QKV, const float* sinks, bf16_t* AO) {
    constexpr int KB = 0, VT = 36864;
    constexpr float L2E = 1.4426950408889634f;
    LAS unsigned char* lds = F.lds;
    const int tid = F.tid, lane = F.lane, w = F.wave, q4 = lane >> 4, r16 = lane & 15;
    const LAS unsigned char* kbase = lds + KB + (16 * w + r16) * 144 + q4 * 16;
    const LAS unsigned char* vbase = lds + VT + r16 * 528 + (16 * w + 4 * q4) * 2;
    LAS float* sinkl = (LAS float*)(lds + 70656);
    if (tid < 16) sinkl[tid] = sinks[tid];
    for (int unit = blockIdx.x; unit < 512; unit += F.G) {
        const int kh = unit & 1, n = (unit >> 1) & 15, b = unit >> 5;
        const long tokq0 = (long)b * SEQ + n * 128, tokk0 = tokq0 - 128;
        { const int row0 = tid >> 3, c8 = tid & 7;
          const bf16_t* src0 = QKV + (size_t)(tokk0 + row0) * QKV_N + 1024 + kh * 64 + c8 * 8;
          LAS unsigned char* kdst = lds + KB + row0 * 144 + c8 * 16; LAS unsigned char* vdst = lds + VT + c8 * (8 * 528) + row0 * 2;
#pragma unroll
          for (int i = 0; i < 4; ++i) {
              u32x4 kv = (u32x4){0u, 0u, 0u, 0u}, vv = (u32x4){0u, 0u, 0u, 0u};
              if ((n > 0) || (i >= 2)) { kv = *(const u32x4*)(src0 + (size_t)i * 64 * QKV_N); vv = *(const u32x4*)(src0 + (size_t)i * 64 * QKV_N + 128); }
              *(LAS u32x4*)(kdst + i * 64 * 144) = kv;
              const unsigned wv[4] = {vv.x, vv.y, vv.z, vv.w};
#pragma unroll
              for (int j = 0; j < 4; ++j) { *(LAS bf16_t*)(vdst + (2 * j) * 528 + i * 128) = (bf16_t)(wv[j] & 0xffffu); *(LAS bf16_t*)(vdst + (2 * j + 1) * 528 + i * 128) = (bf16_t)(wv[j] >> 16); } } }
        const size_t qtok = (size_t)(tokq0 + 16 * w + r16);
        const bf16_t* qrow = QKV + qtok * QKV_N + kh * 512 + q4 * 8;
        bf16x8 qn[2][2];
#pragma unroll
        for (int hh = 0; hh < 2; ++hh)
#pragma unroll
            for (int s2 = 0; s2 < 2; ++s2) qn[hh][s2] = *(const bf16x8*)(qrow + hh * 64 + 32 * s2);
        __syncthreads();
        float cm[4];
#pragma unroll
        for (int rr = 0; rr < 4; ++rr) cm[rr] = (float)(r16 - 4 * q4 - rr);
#pragma unroll 1
        for (int gp = 0; gp < 4; ++gp) {
            asm volatile("" ::: "memory");
            bf16x8 qc[2][2];
#pragma unroll
            for (int hh = 0; hh < 2; ++hh)
#pragma unroll
                for (int s2 = 0; s2 < 2; ++s2) qc[hh][s2] = qn[hh][s2];
            if (gp < 3) {
#pragma unroll
                for (int hh = 0; hh < 2; ++hh)
#pragma unroll
                    for (int s2 = 0; s2 < 2; ++s2) qn[hh][s2] = *(const bf16x8*)(qrow + (2 * gp + 2 + hh) * 64 + 32 * s2); }
            f32x4 sc[2][9];
#pragma unroll
            for (int kt = 0; kt < 9; ++kt) { sc[0][kt] = (f32x4){0.f, 0.f, 0.f, 0.f}; sc[1][kt] = (f32x4){0.f, 0.f, 0.f, 0.f};
#pragma unroll
                for (int s2 = 0; s2 < 2; ++s2) { const bf16x8 kf = *(const LAS bf16x8*)(kbase + kt * 2304 + s2 * 64);
                    sc[0][kt] = __builtin_amdgcn_mfma_f32_16x16x32_bf16(kf, qc[0][s2], sc[0][kt], 0, 0, 0); sc[1][kt] = __builtin_amdgcn_mfma_f32_16x16x32_bf16(kf, qc[1][s2], sc[1][kt], 0, 0, 0); } }
            float inv[2];
#pragma unroll
            for (int hh = 0; hh < 2; ++hh) {
                const int hq = kh * 8 + 2 * gp + hh; const float slope2 = exp2f(-0.5f * (float)(hq + 1)) * L2E, sink2 = sinkl[hq] * L2E;
                const f32x2 nb0 = (f32x2){-slope2 * cm[0], -slope2 * cm[1]}, nb1 = (f32x2){-slope2 * cm[2], -slope2 * cm[3]};
                float mx = -1e30f;
#pragma unroll
                for (int kt = 0; kt < 9; ++kt) { const bool tile_ok = (n > 0) || (w + kt >= 8); const float tkn = -slope2 * (float)(128 - 16 * kt);
                    f32x2 v0 = (f32x2){sc[hh][kt][0], sc[hh][kt][1]} * (0.125f * L2E) + (nb0 + tkn), v1 = (f32x2){sc[hh][kt][2], sc[hh][kt][3]} * (0.125f * L2E) + (nb1 + tkn);
                    float vv[4] = {v0.x, v0.y, v1.x, v1.y};
#pragma unroll
                    for (int rr = 0; rr < 4; ++rr) { bool ok = tile_ok; if (kt == 0) ok = ok && (cm[rr] < 0.f); if (kt == 8) ok = ok && (cm[rr] >= 0.f);
                        if (kt == 0 || kt == 8) vv[rr] = ok ? vv[rr] : -1e30f; else vv[rr] = tile_ok ? vv[rr] : -1e30f; sc[hh][kt][rr] = vv[rr]; }
                    mx = fmaxf(mx, fmaxf(fmaxf(vv[0], vv[1]), fmaxf(vv[2], vv[3]))); }
                mx = fmaxf(mx, __shfl_xor(mx, 16)); mx = fmaxf(mx, __shfl_xor(mx, 32)); mx = fmaxf(mx, sink2);
                f32x2 l2 = (f32x2){0.f, 0.f};
#pragma unroll
                for (int kt = 0; kt < 9; ++kt) { const f32x2 d0 = (f32x2){sc[hh][kt][0], sc[hh][kt][1]} - mx, d1 = (f32x2){sc[hh][kt][2], sc[hh][kt][3]} - mx;
                    const f32x2 p0 = (f32x2){__builtin_amdgcn_exp2f(d0.x), __builtin_amdgcn_exp2f(d0.y)}, p1 = (f32x2){__builtin_amdgcn_exp2f(d1.x), __builtin_amdgcn_exp2f(d1.y)};
                    sc[hh][kt] = (f32x4){p0.x, p0.y, p1.x, p1.y}; l2 = l2 + (p0 + p1); }
                float l = l2.x + l2.y;
                l += __shfl_xor(l, 16); l += __shfl_xor(l, 32); l += __builtin_amdgcn_exp2f(sink2 - mx);
                inv[hh] = __builtin_amdgcn_rcpf(l); }
            f32x4 o[2][4];
#pragma unroll
            for (int dt = 0; dt < 4; ++dt) { o[0][dt] = (f32x4){0.f, 0.f, 0.f, 0.f}; o[1][dt] = (f32x4){0.f, 0.f, 0.f, 0.f}; }
#pragma unroll
            for (int c = 0; c < 5; ++c) {
                bf16x8 pf[2];
#pragma unroll
                for (int hh = 0; hh < 2; ++hh) { u32x4 pw4; pw4.x = cvt_pk_bf16(sc[hh][2 * c][0], sc[hh][2 * c][1]); pw4.y = cvt_pk_bf16(sc[hh][2 * c][2], sc[hh][2 * c][3]);
                    if (c < 4) { pw4.z = cvt_pk_bf16(sc[hh][2 * c + 1][0], sc[hh][2 * c + 1][1]); pw4.w = cvt_pk_bf16(sc[hh][2 * c + 1][2], sc[hh][2 * c + 1][3]); } else { pw4.z = 0u; pw4.w = 0u; }
                    pf[hh] = __builtin_bit_cast(bf16x8, pw4); }
#pragma unroll
                for (int dt = 0; dt < 4; ++dt) { const u32x2 vlo = *(const LAS u32x2*)(vbase + dt * 8448 + (2 * c) * 32);
                    u32x2 vhi = (u32x2){0u, 0u}; if (c < 4) vhi = *(const LAS u32x2*)(vbase + dt * 8448 + (2 * c + 1) * 32);
                    const bf16x8 vf = __builtin_bit_cast(bf16x8, (u32x4){vlo.x, vlo.y, vhi.x, vhi.y});
                    o[0][dt] = __builtin_amdgcn_mfma_f32_16x16x32_bf16(vf, pf[0], o[0][dt], 0, 0, 0); o[1][dt] = __builtin_amdgcn_mfma_f32_16x16x32_bf16(vf, pf[1], o[1][dt], 0, 0, 0); } }
#pragma unroll
            for (int hh = 0; hh < 2; ++hh)
#pragma unroll
                for (int dt = 0; dt < 4; ++dt) *(u32x2*)(AO + qtok * D + (kh * 8 + 2 * gp + hh) * 64 + 16 * dt + 4 * q4) = (u32x2){cvt_pk_bf16(o[hh][dt][0] * inv[hh], o[hh][dt][1] * inv[hh]), cvt_pk_bf16(o[hh][dt][2] * inv[hh], o[hh][dt][3] * inv[hh])};
        }
        __syncthreads();
    }
}

struct MoeMeta { int* re; float* rw; int* pos; int* cnt; int* tile; };
template <bool FP8>
DI void moe_route_phase(const Frame& F, const bf16_t* X, const float* gain, const float* wr, bf16_t* XN, const MoeMeta& mm) {
    LAS float* wl = (LAS float*)F.lds;
    LAS int* cl = (LAS int*)(F.lds + 32768);
    for (int q = F.tid; q < 2048; q += NTHR) { const int k = q >> 1, h = q & 1, L = (k & 255) >> 2, i = k & 3, j = k >> 8; ((LAS f32x4*)wl)[((j * 4 + i) * 2 + h) * 64 + L] = *(const f32x4*)(wr + 4 * q); }
    f32x4 gv[4]; load_row(gain, F.lane, gv);
    for (int blk = blockIdx.x; blk < T / 128; blk += F.G) {
        if (F.tid < 8) cl[F.tid] = 0;
        __syncthreads();
        f32x4 vn[4]; load_row(X + (size_t)(blk * 128 + F.wave * 16) * D, F.lane, vn);
        for (int ti = 0; ti < 16; ++ti) { const int t = blk * 128 + F.wave * 16 + ti;
            f32x4 v[4];
#pragma unroll
            for (int j = 0; j < 4; ++j) v[j] = vn[j];
            if (ti < 15) load_row(X + (size_t)(t + 1) * D, F.lane, vn);
            const float rs = row_rstd(v);
            float lg[8];
#pragma unroll
            for (int e = 0; e < 8; ++e) lg[e] = 0.f;
#pragma unroll
            for (int j = 0; j < 4; ++j) { float hv[4];
#pragma unroll
                for (int i = 0; i < 4; ++i) hv[i] = v[j][i] * rs * gv[j][i];
                if constexpr (FP8) { *(unsigned*)((unsigned char*)XN + (size_t)t * D + 4 * F.lane + 256 * j) = cvt4_fp8(hv[0], hv[1], hv[2], hv[3]); }
                else { u32x2 w; w.x = cvt_pk_bf16(hv[0], hv[1]); w.y = cvt_pk_bf16(hv[2], hv[3]); *(u32x2*)(XN + (size_t)t * D + 4 * F.lane + 256 * j) = w; }
#pragma unroll
                for (int i = 0; i < 4; ++i) { const LAS f32x4* wp = (const LAS f32x4*)wl + ((j * 4 + i) * 2) * 64 + F.lane; const f32x4 w0 = wp[0], w1 = wp[64];
                    lg[0] += hv[i] * w0[0]; lg[1] += hv[i] * w0[1]; lg[2] += hv[i] * w0[2]; lg[3] += hv[i] * w0[3]; lg[4] += hv[i] * w1[0]; lg[5] += hv[i] * w1[1]; lg[6] += hv[i] * w1[2]; lg[7] += hv[i] * w1[3]; } }
#pragma unroll
            for (int e = 0; e < 8; ++e) lg[e] = wave_sum(lg[e]);
            int e0 = 0; float v0 = lg[0];
#pragma unroll
            for (int e = 1; e < 8; ++e) if (lg[e] > v0) { v0 = lg[e]; e0 = e; }
            int e1 = -1; float v1 = -3.0e38f;
#pragma unroll
            for (int e = 0; e < 8; ++e) if (e != e0 && lg[e] > v1) { v1 = lg[e]; e1 = e; }
            if (F.lane == 0) { const float ex = expf(v1 - v0), w0 = 1.f / (1.f + ex); mm.re[t] = e0 | (e1 << 8); mm.rw[2 * t] = w0; mm.rw[2 * t + 1] = ex * w0; __hip_atomic_fetch_add(cl + e0, 1, __ATOMIC_RELAXED, __HIP_MEMORY_SCOPE_WORKGROUP); __hip_atomic_fetch_add(cl + e1, 1, __ATOMIC_RELAXED, __HIP_MEMORY_SCOPE_WORKGROUP); }
        }
        __syncthreads();
        if (F.tid < 8) mm.cnt[blk * 8 + F.tid] = cl[F.tid];
        __syncthreads();
    }
}
template <bool FP8>
DI void moe_dispatch_phase(const Frame& F, const bf16_t* XN, bf16_t* XS, const MoeMeta& mm) {
    LAS int* pre = (LAS int*)F.lds;
    LAS int* base = (LAS int*)(F.lds + 8192);
    LAS int* posl = (LAS int*)(F.lds + 8192 + 64);
    constexpr int NB = T / 128;
    for (int i = F.tid; i < NB * 8; i += NTHR) pre[i] = __hip_atomic_load(mm.cnt + i, __ATOMIC_RELAXED, __HIP_MEMORY_SCOPE_AGENT);
    __syncthreads();
    {
      static_assert(NB == 256 && NWAVES == 8, "one wave per expert, four blocks per lane");
      const int e = F.wave; int cb[4], s = 0;
#pragma unroll
      for (int k = 0; k < 4; ++k) { cb[k] = pre[(4 * F.lane + k) * 8 + e]; s += cb[k]; }
      int inc = s;
#pragma unroll
      for (int off = 1; off < 64; off <<= 1) { const int o = __shfl_up(inc, off); if (F.lane >= off) inc += o; }
      int run = inc - s;
#pragma unroll
      for (int k = 0; k < 4; ++k) { pre[(4 * F.lane + k) * 8 + e] = run; run += cb[k]; }
      if (F.lane == 63) base[8 + e] = (inc + 255) & ~255; }
    __syncthreads();
    if (F.tid == 0) { int run = 0; for (int e = 0; e < 8; ++e) { base[e] = run; run += base[8 + e]; }
        if (blockIdx.x == 0) { int nt = 0; for (int e = 0; e < 8; ++e) { const int ntile = base[8 + e] >> 8; for (int k = 0; k < ntile; ++k) mm.tile[nt + k] = e; nt += ntile; } mm.tile[MOE_TILES] = nt; } }
    __syncthreads();
    for (int blk = blockIdx.x; blk < NB; blk += F.G) {
        if (F.wave == 0) { int run[8];
#pragma unroll
            for (int e = 0; e < 8; ++e) run[e] = base[e] + pre[blk * 8 + e];
            for (int hf = 0; hf < 2; ++hf) { const int tl = hf * 64 + F.lane, t = blk * 128 + tl; const int re = __hip_atomic_load(mm.re + t, __ATOMIC_RELAXED, __HIP_MEMORY_SCOPE_AGENT), e0 = re & 255, e1 = re >> 8; int p0 = 0, p1 = 0;
#pragma unroll
                for (int e = 0; e < 8; ++e) { const unsigned long long m = __ballot((e0 == e) || (e1 == e)); const int rank = __popcll(m & ((1ull << F.lane) - 1ull));
                    if (e0 == e) p0 = run[e] + rank; if (e1 == e) p1 = run[e] + rank; run[e] += __popcll(m); }
                posl[2 * tl] = p0; posl[2 * tl + 1] = p1; mm.pos[2 * t] = p0; mm.pos[2 * t + 1] = p1; } }
        __syncthreads();
        for (int rc = F.wave; rc < 256; rc += NWAVES) { const int tl = rc >> 1, t = blk * 128 + tl, ps = posl[rc];
            if constexpr (FP8) { *((u32x4*)((unsigned char*)XS + (size_t)ps * D) + F.lane) = *((const u32x4*)((const unsigned char*)XN + (size_t)t * D) + F.lane); }
            else { const u32x4* src = (const u32x4*)(XN + (size_t)t * D) + 2 * F.lane; u32x4* dst = (u32x4*)(XS + (size_t)ps * D) + 2 * F.lane; const u32x4 a = src[0], c = src[1]; dst[0] = a; dst[1] = c; } }
        __syncthreads();
    }
}
template <bool FINAL>
DI void moe_combine_phase(const Frame& F, bf16_t* X, const bf16_t* YS, const bf16_t* PART, const MoeMeta& mm, const float* gain, bf16_t* XN, float* OUT) {
    f32x4 gv[4]; load_row(gain, F.lane, gv);
    int nsr; { int R, nsp; pg8::sk_split(__hip_atomic_load(mm.tile + MOE_TILES, __ATOMIC_RELAXED, __HIP_MEMORY_SCOPE_AGENT), D / 256, F.G, R, nsp); nsr = nsp * 256; }
    for (int t = F.gw; t < T; t += F.ngw) {
        const int p0 = __hip_atomic_load(mm.pos + 2 * t, __ATOMIC_RELAXED, __HIP_MEMORY_SCOPE_AGENT), p1 = __hip_atomic_load(mm.pos + 2 * t + 1, __ATOMIC_RELAXED, __HIP_MEMORY_SCOPE_AGENT);
        const float w0 = __hip_atomic_load(mm.rw + 2 * t, __ATOMIC_RELAXED, __HIP_MEMORY_SCOPE_AGENT), w1 = __hip_atomic_load(mm.rw + 2 * t + 1, __ATOMIC_RELAXED, __HIP_MEMORY_SCOPE_AGENT);
        f32x4 v[4]; load_row(X + (size_t)t * D, F.lane, v);
#pragma unroll
        for (int j = 0; j < 4; ++j) { const u32x2 a = *(const u32x2*)(YS + (size_t)p0 * D + 4 * F.lane + 256 * j), c = *(const u32x2*)(YS + (size_t)p1 * D + 4 * F.lane + 256 * j);
            v[j][0] += w0 * bf_lo(a.x) + w1 * bf_lo(c.x); v[j][1] += w0 * bf_hi(a.x) + w1 * bf_hi(c.x); v[j][2] += w0 * bf_lo(a.y) + w1 * bf_lo(c.y); v[j][3] += w0 * bf_hi(a.y) + w1 * bf_hi(c.y); }
        if (p0 < nsr || p1 < nsr) {
#pragma unroll 1
            for (int s = 0; s < 2; ++s) { const int p = s ? p1 : p0; const float w = s ? w1 : w0; if (p >= nsr) continue;
#pragma unroll 1
                for (int ch = 0; ch < pg8::SK_NCH - 1; ++ch) { const bf16_t* pp = PART + (size_t)ch * SK_PART_STRIDE + (size_t)p * D + 4 * F.lane;
#pragma unroll
                    for (int j = 0; j < 4; ++j) { const u32x2 a = *(const u32x2*)(pp + 256 * j); v[j][0] += w * bf_lo(a.x); v[j][1] += w * bf_hi(a.x); v[j][2] += w * bf_lo(a.y); v[j][3] += w * bf_hi(a.y); } } }
        }
        const float rs = row_rstd(v);
#pragma unroll
        for (int j = 0; j < 4; ++j) {
            if (FINAL) { *(f32x4*)(OUT + (size_t)t * D + 4 * F.lane + 256 * j) = (f32x4){v[j][0] * rs * gv[j][0], v[j][1] * rs * gv[j][1], v[j][2] * rs * gv[j][2], v[j][3] * rs * gv[j][3]}; }
            else { *(u32x2*)(X + (size_t)t * D + 4 * F.lane + 256 * j) = (u32x2){cvt_pk_bf16(v[j][0], v[j][1]), cvt_pk_bf16(v[j][2], v[j][3])};
                u32x2 w; w.x = cvt_pk_bf16(v[j][0] * rs * gv[j][0], v[j][1] * rs * gv[j][1]); w.y = cvt_pk_bf16(v[j][2] * rs * gv[j][2], v[j][3] * rs * gv[j][3]); *(u32x2*)(XN + (size_t)t * D + 4 * F.lane + 256 * j) = w; } }
    }
}

constexpr int NPHASE = 33;
struct Args { const float* in[50]; float* out; unsigned char* ws; int ph_lo, ph_hi; };
__global__ void __launch_bounds__(NTHR, 2) trunk_fwd(Args args) {
    extern __shared__ __attribute__((aligned(16))) unsigned char lds_raw[];
    Frame F;
    F.lds = (LAS unsigned char*)lds_raw;
    F.tid = threadIdx.x; F.lane = F.tid & 63; F.wave = __builtin_amdgcn_readfirstlane(F.tid >> 6);
    F.G = gridDim.x; F.gw = blockIdx.x * NWAVES + F.wave; F.ngw = F.G * NWAVES;
    const Frame F0 = F;
    unsigned char* ws = args.ws;
    volatile LAS unsigned* MISC = (volatile LAS unsigned*)(F.lds + LDS_MISC_OFF);
    if (F.tid < 64) MISC[F.tid] = 0u;
    __syncthreads();
#if !MK_PER_PHASE
    XcdBarrier bar = xcd_barrier_post((unsigned*)(ws + WS_CTL) + CW_BAR, MISC + 8);
#define GRID_BAR() xcd_barrier(bar)
#else
#define GRID_BAR() do {} while (0)
#endif
    const int lo = args.ph_lo, hi = args.ph_hi;
#define IN(k) (lo <= (k) && (k) < hi)
#define SEAM(k) do { if (IN(k) && IN((k) + 1)) GRID_BAR(); } while (0)
    LAS unsigned char* lds = F.lds;
    const int G = F.G, c = (int)blockIdx.x;
    bf16_t* XN = (bf16_t*)(ws + WS_XN);
    unsigned char* WA = ws + WS_WA; unsigned char* ACT = ws + WS_ACT;
    bf16_t* XRES = (bf16_t*)(ACT + AC_XB);

#define S5_PARAMS(base) S5P{args.in[(base)], args.in[(base) + 1], args.in[(base) + 2], args.in[(base) + 3], args.in[(base) + 4], args.in[(base) + 5], args.in[(base) + 6], args.in[(base) + 7], args.in[(base) + 8], args.in[(base) + 9]}
#define S5_PREP(pbase, xin, ln) { const S5P sp = S5_PARAMS(pbase); \
        convert_matrix(F, sp.w_glu, D, D, D, (bf16_t*)(WA + WA_WGLU), D, RowId{}, 1, 0, 0); \
        __syncthreads(); s5_tables_phase(F, sp, (bf16_t*)(WA + WA_TG), (bf16_t*)(WA + WA_FG)); \
        norm_to_ug_phase(F, xin, ln, (bf16_t*)(ACT + AC_UG), XRES); }
#define S5_SLOC(pbase) { pg8::Gemm g{(const bf16_t*)(ACT + AC_UG), (const bf16_t*)(WA + WA_FG), S5LD, S5K, S5K}; \
        pg8::BatchOrder S{64, S5ROWS / 256, 1, G, c, 256L * S5LD * 2, 256L * S5K * 2, (long)S5ROWS * S5LD * 2, 256L * S5K * 2}; \
        pg8::EpiSloc E{(float*)(ACT + AC_SLOC)}; pg8::gemm_phase(lds, F.tid, g, S, E); \
        __syncthreads();     \
        { const S5P sp = S5_PARAMS(pbase); pg8::Unit u; for (int i = 0; S.next(i, u); ++i) s5_scan_tile(F, sp, (const float*)(ACT + AC_SLOC), (bf16_t*)(ACT + AC_UG), u.aux, u.pm); } }
#define S5_SCAN(pbase) { const S5P sp = S5_PARAMS(pbase); s5_scan_phase(F, sp, (const float*)(ACT + AC_SLOC), (bf16_t*)(ACT + AC_UG)); }
#define S5_Y(pbase) { pg8::Gemm g{(const bf16_t*)(ACT + AC_UG), (const bf16_t*)(WA + WA_TG), S5LD, S5LD, S5LD}; \
        pg8::BatchOrder S{64, S5ROWS / 256, S5K / 256, G, c, 256L * S5LD * 2, 256L * S5LD * 2, (long)S5ROWS * S5LD * 2, (long)S5K * S5LD * 2}; \
        pg8::EpiS5Y E{(bf16_t*)(ACT + AC_YMAT)}; pg8::gemm_phase(lds, F.tid, g, S, E); }
#define S5_GLU(pbase, xin, XBF) { pg8::Gemm g{(const bf16_t*)(ACT + AC_YMAT), (const bf16_t*)(WA + WA_WGLU), 16, D, D, T * 32}; \
        pg8::PlainOrder S; S.init(T, D, G, c, 16, D); pg8::EpiGlu<XBF> E{xin, XRES, (const bf16_t*)(ACT + AC_YMAT), args.in[(pbase) + 9]}; pg8::gemm_phase(lds, F.tid, g, S, E); }
#define FFN_CONVERT(wbase) do { convert_matrix(F, args.in[(wbase)], D, 2 * FFN_H, 2 * FFN_H, (bf16_t*)(WA + WA_FGU), D, RowGU{FFN_H}, 1, 0, 0); \
        convert_matrix(F, args.in[(wbase) + 1], FFN_H, D, D, (bf16_t*)(WA + WA_FDN), FFN_H, RowId{}, 1, 0, 0); } while (0)
#define FFN_CONVERT8(wbase) do { convert_matrix8(F, args.in[(wbase)], D, 2 * FFN_H, 2 * FFN_H, (unsigned char*)(WA + WA_FGU), D, RowGU{FFN_H}, 1, 0, 0); \
        convert_matrix8(F, args.in[(wbase) + 1], FFN_H, D, D, (unsigned char*)(WA + WA_FDN), FFN_H, RowId{}, 1, 0, 0); } while (0)
#define FFN_GU8() { pg8::Gemm g{XN, (const bf16_t*)(WA + WA_FGU), D / 2, D / 2, D / 2}; pg8::PlainOrder S; S.init(T, 2 * FFN_H, G, c, D / 2, D / 2); \
        pg8::EpiSwiGLU8 E{(unsigned char*)(ACT + AC_H), (size_t)T * 32}; pg8::gemm_phase<pg8::EpiSwiGLU8, pg8::PlainOrder, true>(lds, F.tid, g, S, E); }
#define FFN_DN8() { pg8::Gemm g{(const bf16_t*)(ACT + AC_H), (const bf16_t*)(WA + WA_FDN), 16, FFN_H / 2, FFN_H / 2, T * 32}; pg8::PlainOrder S; S.init(T, D, G, c, 16, FFN_H / 2);     \
        pg8::EpiResAdd E{XRES, nullptr}; pg8::gemm_phase<pg8::EpiResAdd, pg8::PlainOrder, true>(lds, F.tid, g, S, E); }
#define FFN_GU() { pg8::Gemm g{XN, (const bf16_t*)(WA + WA_FGU), D, D, D}; pg8::PlainOrderB S; S.init(T, 2 * FFN_H, G, c, D, D); \
        pg8::EpiSwiGLU E{(bf16_t*)(ACT + AC_H), FFN_H}; pg8::gemm_phase(lds, F.tid, g, S, E); }
#define FFN_DN() { pg8::Gemm g{(const bf16_t*)(ACT + AC_H), (const bf16_t*)(WA + WA_FDN), FFN_H, FFN_H, FFN_H}; pg8::PlainOrder S; S.init(T, D, G, c, FFN_H, FFN_H); \
        pg8::EpiResAdd E{XRES, nullptr}; pg8::gemm_phase(lds, F.tid, g, S, E); }
#define MOE_META(set) MoeMeta{(int*)(ws + WS_MISC + (set) * MS_SET + MS_RE), (float*)(ws + WS_MISC + (set) * MS_SET + MS_RW), (int*)(ws + WS_MISC + (set) * MS_SET + MS_POS), \
        (int*)(ws + WS_MISC + (set) * MS_SET + MS_CNT), (int*)(ws + WS_MISC + (set) * MS_SET + MS_TILE)}
#define MOE_ROUTE(set, ln, wbase) { const MoeMeta mm = MOE_META(set); \
        convert_matrix(F, args.in[(wbase) + 1], D, 2 * EXP_H, 2 * EXP_H, (bf16_t*)(WA + WA_MGU), D, RowGU{EXP_H}, NEXP, (size_t)D * 2 * EXP_H, (size_t)D * 2 * EXP_H); \
        convert_matrix(F, args.in[(wbase) + 2], EXP_H, D, D, (bf16_t*)(WA + WA_MDN), EXP_H, RowId{}, NEXP, (size_t)D * EXP_H, (size_t)D * EXP_H); \
        __syncthreads(); moe_route_phase<false>(F, XRES, ln, args.in[(wbase)], XN, mm); }
#define MOE_ROUTE8(set, ln, wbase) { const MoeMeta mm = MOE_META(set); \
        convert_matrix8(F, args.in[(wbase) + 1], D, 2 * EXP_H, 2 * EXP_H, (unsigned char*)(WA + WA_MGU), D, RowGU{EXP_H}, NEXP, (size_t)D * 2 * EXP_H, (size_t)D * 2 * EXP_H); \
        convert_matrix8(F, args.in[(wbase) + 2], EXP_H, D, D, (unsigned char*)(WA + WA_MDN), EXP_H, RowId{}, NEXP, (size_t)D * EXP_H, (size_t)D * EXP_H); \
        __syncthreads(); moe_route_phase<true>(F, XRES, ln, args.in[(wbase)], XN, mm); }
#define MOE_DISPATCH(set) { const MoeMeta mm = MOE_META(set); moe_dispatch_phase<false>(F, XN, (bf16_t*)(ACT + AC_XS), mm); }
#define MOE_DISPATCH8(set) { const MoeMeta mm = MOE_META(set); moe_dispatch_phase<true>(F, XN, (bf16_t*)(ACT + AC_XS), mm); }
#define MOE_LOAD_TILES(set) const MoeMeta mm = MOE_META(set); LAS int* tl = (LAS int*)(lds + LDS_MISC_OFF + 256); \
        for (int i = F.tid; i <= MOE_TILES; i += NTHR) tl[i] = __hip_atomic_load(mm.tile + i, __ATOMIC_RELAXED, __HIP_MEMORY_SCOPE_AGENT); __syncthreads(); \
        const int ntile = tl[MOE_TILES];
#define MOE_GU(set) { MOE_LOAD_TILES(set) pg8::Gemm g{(const bf16_t*)(ACT + AC_XS), (const bf16_t*)(WA + WA_MGU), D, D, D}; \
        pg8::MoeOrder S{ntile, 2 * EXP_H / 256, G, c, 256L * D * 2, 256L * D * 2, (long)2 * EXP_H * D * 2, tl, 0}; \
        pg8::EpiSwiGLU E{(bf16_t*)(ACT + AC_HID), EXP_H}; pg8::gemm_phase(lds, F.tid, g, S, E); }
#define MOE_DN(set) { MOE_LOAD_TILES(set) pg8::Gemm g{(const bf16_t*)(ACT + AC_HID), (const bf16_t*)(WA + WA_MDN), EXP_H, EXP_H, EXP_H}; \
        pg8::MoeOrder S{ntile, D / 256, G, c, 256L * EXP_H * 2, 256L * EXP_H * 2, (long)D * EXP_H * 2, tl, 1}; \
        pg8::EpiStoreBf16 E{(bf16_t*)(ACT + AC_XS), D, nullptr}; pg8::gemm_phase(lds, F.tid, g, S, E); }
#define MOE_GU8(set) { MOE_LOAD_TILES(set) pg8::Gemm g{(const bf16_t*)(ACT + AC_XS), (const bf16_t*)(WA + WA_MGU), D / 2, D / 2, D / 2}; \
        pg8::MoeOrder S{ntile, 2 * EXP_H / 256, G, c, 256L * D, 256L * D, (long)2 * EXP_H * D, tl, 0}; \
        pg8::EpiSwiGLU8 E{(unsigned char*)(ACT + AC_HID), HID_GS}; pg8::gemm_phase<pg8::EpiSwiGLU8, pg8::MoeOrder, true>(lds, F.tid, g, S, E); }
#define MOE_DN8(set) { MOE_LOAD_TILES(set) pg8::Gemm g{(const bf16_t*)(ACT + AC_HID), (const bf16_t*)(WA + WA_MDN), 16, EXP_H / 2, EXP_H / 2, (int)HID_GS};     \
        pg8::MoeOrderSK S{ntile, D / 256, G, c, 256L * 32, 256L * EXP_H, (long)D * EXP_H, tl, (long)((AC_PART - AC_XS) / 2), (long)SK_PART_STRIDE, 4L * (long)HID_GS, 0, 0}; S.init(); \
        pg8::EpiStoreBf16 E{(bf16_t*)(ACT + AC_XS), D, nullptr}; pg8::gemm_phase<pg8::EpiStoreBf16, pg8::MoeOrderSK, true>(lds, F.tid, g, S, E); }

#define PH_REPS(k) (1 + PROBE_N * (int)(((unsigned long long)(PROBE_MASK) >> (k)) & 1ull))
#define PH(k, ...) do { for (int _r = 0; _r < PH_REPS(k); ++_r) { if (IN(k)) { Frame F = F0; { int _t = threadIdx.x; asm volatile("" : "+v"(_t)); F.tid = _t; F.lane = _t & 63; F.wave = __builtin_amdgcn_readfirstlane(_t >> 6); F.gw = blockIdx.x * NWAVES + F.wave; } \
        __VA_ARGS__ } if (_r + 1 < PH_REPS(k)) GRID_BAR(); } SEAM(k); } while (0)
    PH(0, S5_PREP(2, args.in[0], args.in[1]) if (FFN0_FP8) { FFN_CONVERT8(13); } else { FFN_CONVERT(13); });
    PH(1, S5_SLOC(2));
    PH(2, S5_Y(2));
    PH(3, S5_GLU(2, XRES, true));
    PH(4, norm_phase<FFN0_FP8 != 0>(F, XRES, args.in[12], XN););
    PH(5, if (FFN0_FP8) FFN_GU8() else FFN_GU());
    PH(6, if (FFN0_FP8) FFN_DN8() else FFN_DN());
    PH(7, convert_matrix(F, args.in[16], D, 3072, 3088, (bf16_t*)(WA + WA_WIN), D, RowId{}, 1, 0, 0);
          for (int id = blockIdx.x * NTHR + F.tid; id < 16 * D; id += G * NTHR) { const int j = id >> 10, k = id & 1023; ((bf16_t*)(WA + WA_WIN))[(size_t)(3072 + j) * D + k] = f2bf(args.in[16][(size_t)k * 3088 + 3072 + j]); }
          convert_matrix(F, args.in[20], D, D, D, (bf16_t*)(WA + WA_WOUT), D, RowId{}, 1, 0, 0);
          norm_phase(F, XRES, args.in[15], XN););
    PH(8, { pg8::Gemm g{XN, (const bf16_t*)(WA + WA_WIN), D, D, D}; pg8::PlainOrderB S; S.init(T, 3072, G, c, D, D); pg8::EpiStoreBf16 E{(bf16_t*)(ACT + AC_PROJ), GLA_N, nullptr}; pg8::gemm_phase(lds, F.tid, g, S, E);
        gla_glow_phase(F, XN, (const bf16_t*)(WA + WA_WIN) + (size_t)3072 * D, (bf16_t*)(ACT + AC_PROJ)); });
    PH(9, gla_prep_phase(F, (const bf16_t*)(ACT + AC_PROJ), args.in[17], args.in[18], (bf16_t*)(ACT + AC_QSB), (bf16_t*)(ACT + AC_KE), (bf16_t*)(ACT + AC_SCB), (float*)(ACT + AC_DEC)););
    PH(10, gla_seq_phase(F, (const bf16_t*)(ACT + AC_QSB), (const bf16_t*)(ACT + AC_KE), (const bf16_t*)(ACT + AC_SCB), (const bf16_t*)(ACT + AC_PROJ), (const float*)(ACT + AC_DEC), (bf16_t*)(ACT + AC_GO)););
    PH(11, gla_finalize_phase(F, (const bf16_t*)(ACT + AC_GO), (const bf16_t*)(ACT + AC_PROJ), args.in[19], XN););
    PH(12, { pg8::Gemm g{XN, (const bf16_t*)(WA + WA_WOUT), D, D, D}; pg8::PlainOrder S; S.init(T, D, G, c, D, D); pg8::EpiResAdd E{XRES, nullptr}; pg8::gemm_phase(lds, F.tid, g, S, E); });
    PH(13, MOE_ROUTE8(0, args.in[21], 22));
    PH(14, MOE_DISPATCH8(0));
    PH(15, MOE_GU8(0));
    PH(16, MOE_DN8(0));
    PH(17, { const MoeMeta mm = MOE_META(0);
          convert_matrix(F, args.in[26], D, QKV_N, QKV_N, (bf16_t*)(WA + WA_QKV), D, RowId{}, 1, 0, 0);
          convert_matrix(F, args.in[29], D, D, D, (bf16_t*)(WA + WA_SWO), D, RowId{}, 1, 0, 0);
          if (FFN2_FP8) { FFN_CONVERT8(32); } else { FFN_CONVERT(32); }
          moe_combine_phase<false>(F, XRES, (const bf16_t*)(ACT + AC_XS), (const bf16_t*)(ACT + AC_PART), mm, args.in[25], XN, nullptr); });
    PH(18, { pg8::Gemm g{XN, (const bf16_t*)(WA + WA_QKV), D, D, D}; pg8::PlainOrder S; S.init(T, 1024, G, c, D, D); pg8::EpiStoreBf16 E{(bf16_t*)(ACT + AC_QKV), QKV_N, args.in[27]}; pg8::gemm_phase(lds, F.tid, g, S, E);
        pg8::HalfOrder SH{T / 256, 4, G, c, 256L * D * 2, 256L * D * 2}; pg8::EpiStoreBf16H EH{(bf16_t*)(ACT + AC_QKV), QKV_N, args.in[27]};
        pg8::gemm_phase<pg8::EpiStoreBf16H, pg8::HalfOrder, false, true>(lds, F.tid, g, SH, EH); });
    PH(19, swa_phase(F, (const bf16_t*)(ACT + AC_QKV), args.in[28], (bf16_t*)(ACT + AC_AO)););
    PH(20, { pg8::Gemm g{(const bf16_t*)(ACT + AC_AO), (const bf16_t*)(WA + WA_SWO), D, D, D}; pg8::PlainOrder S; S.init(T, D, G, c, D, D); pg8::EpiResAdd E{XRES, args.in[30]}; pg8::gemm_phase(lds, F.tid, g, S, E); });
    PH(21, norm_phase<FFN2_FP8 != 0>(F, XRES, args.in[31], XN););
    PH(22, if (FFN2_FP8) FFN_GU8() else FFN_GU());
    PH(23, if (FFN2_FP8) FFN_DN8() else FFN_DN());
    PH(24, S5_PREP(35, XRES, args.in[34]));
    PH(25, S5_SLOC(35));
    PH(26, S5_Y(35));
    PH(27, S5_GLU(35, XRES, true));
    PH(28, MOE_ROUTE8(1, args.in[45], 46));
    PH(29, MOE_DISPATCH8(1));
    PH(30, MOE_GU8(1));
    PH(31, MOE_DN8(1));
    PH(32, { const MoeMeta mm = MOE_META(1); moe_combine_phase<true>(F, XRES, (const bf16_t*)(ACT + AC_XS), (const bf16_t*)(ACT + AC_PART), mm, args.in[49], nullptr, args.out); });
}

extern "C" void kernel_launch(void* const* d_in, const int* in_sizes, int n_in, void* d_out, int out_size, void* d_ws, size_t ws_size, hipStream_t stream) {
    static int grid = 0;
    if (grid == 0) {
        if (n_in != 50 || in_sizes[0] != T * D || out_size != T * D || ws_size < WS_END) { fprintf(stderr, "kernel_launch: unexpected problem (n_in %d, in0 %d, out %d, ws %zu < %zu)\n", n_in, n_in > 0 ? in_sizes[0] : -1, out_size, ws_size, (size_t)WS_END); grid = -1; return; }
        int dev = 0, cus = 0, per_cu = 0;
        if (hipGetDevice(&dev) != hipSuccess || hipDeviceGetAttribute(&cus, hipDeviceAttributeMultiprocessorCount, dev) != hipSuccess) { grid = -1; return; }
        if (hipFuncSetAttribute((const void*)trunk_fwd, hipFuncAttributeMaxDynamicSharedMemorySize, LDS_BYTES) != hipSuccess) { fprintf(stderr, "kernel_launch: hipFuncSetAttribute failed\n"); grid = -1; return; }
        if (hipOccupancyMaxActiveBlocksPerMultiprocessor(&per_cu, (const void*)trunk_fwd, NTHR, LDS_BYTES) != hipSuccess || per_cu < 1) fprintf(stderr, "kernel_launch: occupancy query reports %d\n", per_cu);
        (void)hipGetLastError();
        grid = cus;
    }
    if (grid < 0) return;
    (void)hipMemsetAsync((char*)d_ws + WS_CTL, 0, CTL_ZERO_BYTES, stream);
    Args a{};
    for (int i = 0; i < 50; ++i) a.in[i] = (const float*)d_in[i];
    a.out = (float*)d_out; a.ws = (unsigned char*)d_ws;
#if MK_PER_PHASE
    for (int p = 0; p < NPHASE; ++p) { a.ph_lo = p; a.ph_hi = p + 1; hipLaunchKernelGGL(trunk_fwd, dim3(grid), dim3(NTHR), LDS_BYTES, stream, a); }
#else
    a.ph_lo = 0; a.ph_hi = NPHASE; hipLaunchKernelGGL(trunk_fwd, dim3(grid), dim3(NTHR), LDS_BYTES, stream, a);
#endif
}
```
